# Optimizing an MI355X kernel written in HIP

```python
import math
import jax
import jax.numpy as jnp
from jax import lax
import numpy as np


D_MODEL = 2048
BATCH = 4
SEQ = 8192
DEPTH = 1

M_HEADS = 4
M_DQK = 128
M_DV = 256
M_CHUNK = 128
GATE_CAP = 15.0
A_HEADS = 8
A_DH = 64
A_DV = 2 * A_DH
Q_BLOCK = 128
ROPE_THETA = 10000.0
D_FF = -(-8 * D_MODEL // (3 * 256)) * 256
N_BRANCH = 2
EPS = 1e-6
M_WIDTH = M_HEADS * M_DV
A_WIDTH = A_HEADS * A_DV
SPLIT_SIZES = (M_HEADS * M_DQK, M_HEADS * M_DQK, M_WIDTH, M_WIDTH, 4 * M_HEADS,
               A_HEADS * 2 * A_DH, A_HEADS * 2 * A_DH, A_WIDTH, N_BRANCH * D_MODEL)
D_IN = sum(SPLIT_SIZES)
IN_OFFSETS = tuple(int(o) for o in np.cumsum(SPLIT_SIZES)[:-1])

kernel_name = 'hybrid_mlstm_diffattn_encoder'


def _rmsnorm(x, w):
    xf = x.astype(jnp.float32)
    y = xf * lax.rsqrt(jnp.mean(xf * xf, axis=-1, keepdims=True) + EPS)
    return (y * w.astype(jnp.float32)).astype(x.dtype)


def _softcap(t):
    return GATE_CAP * jnp.tanh(t / GATE_CAP)


def _rope(t):
    S = t.shape[1]
    d = t.shape[-1]
    inv = ROPE_THETA ** (-jnp.arange(0, d, 2, dtype=jnp.float32) / d)
    ang = jnp.arange(S, dtype=jnp.float32)[:, None] * inv[None, :]
    cos = jnp.cos(ang)[:, None, None, :]
    sin = jnp.sin(ang)[:, None, None, :]
    tf = t.astype(jnp.float32)
    t1, t2 = tf[..., : d // 2], tf[..., d // 2:]
    return jnp.concatenate([t1 * cos - t2 * sin, t1 * sin + t2 * cos], axis=-1).astype(t.dtype)


def _mlstm_scan(q, k, v, ig, lf):
    B, H, S, Dk = q.shape
    Dv = v.shape[-1]
    L = M_CHUNK
    nc = S // L

    def to_chunks(t):
        return jnp.moveaxis(t.astype(jnp.float32).reshape((B, H, nc, L) + t.shape[3:]), 2, 0)

    xs = tuple(to_chunks(t) for t in (q, k, v, ig, lf))
    tril = jnp.tril(jnp.ones((L, L), dtype=bool))

    def step(carry, inp):
        C, n, m = carry
        qc, kc, vc, igc, lfc = inp
        b = jnp.cumsum(lfc, axis=-1)
        dmat = b[..., :, None] - b[..., None, :] + igc[..., None, :]
        dmat = jnp.where(tril, dmat, -jnp.inf)
        inter = b + m[..., None]
        m_t = jnp.maximum(inter, jnp.max(dmat, axis=-1))
        wts = jnp.exp(dmat - m_t[..., None])
        a = jnp.exp(inter - m_t)
        s = jnp.einsum('bhtd,bhsd->bhts', qc, kc) * wts
        num = a[..., None] * jnp.einsum('bhvd,bhtd->bhtv', C, qc) + jnp.einsum('bhts,bhsv->bhtv', s, vc)
        den = a * jnp.einsum('bhd,bhtd->bht', n, qc) + jnp.sum(s, axis=-1)
        h = num / jnp.maximum(jnp.abs(den), jnp.exp(-m_t))[..., None]
        bL = b[..., -1]
        g = bL[..., None] - b + igc
        m_new = jnp.maximum(bL + m, jnp.max(g, axis=-1))
        decay = jnp.exp(bL + m - m_new)
        wk = jnp.exp(g - m_new[..., None])
        C = decay[..., None, None] * C + jnp.einsum('bhsv,bhsd->bhvd', vc, kc * wk[..., None])
        n = decay[..., None] * n + jnp.einsum('bhs,bhsd->bhd', wk, kc)
        return (C, n, m_new), h

    init = (jnp.zeros((B, H, Dv, Dk), jnp.float32),
            jnp.zeros((B, H, Dk), jnp.float32),
            jnp.zeros((B, H), jnp.float32))
    _, hs = lax.scan(step, init, xs)
    return jnp.moveaxis(hs, 0, 2).reshape(B, H, S, Dv)


def _diff_attention(q, k, v, lam):
    B, S, H, _, dh = q.shape
    nb = S // Q_BLOCK
    qb = jnp.moveaxis(q.reshape(B, nb, Q_BLOCK, H, 2, dh), 1, 0)
    scale = dh ** -0.5

    def block(qi):
        s = jnp.einsum('bqhcd,bkhcd->bhcqk', qi, k).astype(jnp.float32) * scale
        p = jax.nn.softmax(s, axis=-1)
        p = p[:, :, 0] - lam * p[:, :, 1]
        return jnp.einsum('bhqk,bkhv->bqhv', p.astype(v.dtype), v)

    o = lax.map(block, qb)
    return jnp.moveaxis(o, 0, 1).reshape(B, S, H, v.shape[-1])


def setup_inputs(seed: int = 0) -> dict:
    key = jax.random.key(seed)
    ks = jax.random.split(key, 20)
    f32 = jnp.float32

    def w(k, shape, fan_in):
        return jax.random.normal(k, shape, f32) * fan_in ** -0.5

    def gain(k, shape):
        return 1.0 + 0.02 * jax.random.normal(k, shape, f32)

    x = jax.random.normal(ks[0], (BATCH, SEQ, D_MODEL), f32)
    norm1_w = gain(ks[1], (DEPTH, D_MODEL))
    w_in = w(ks[2], (DEPTH, D_MODEL, D_IN), D_MODEL)
    b_igate = 0.1 * jax.random.normal(ks[3], (DEPTH, 2, M_HEADS), f32)
    b_fgate = jnp.linspace(3.0, 6.0, M_HEADS, dtype=f32)[None, None, :] + 0.1 * jax.random.normal(ks[4], (DEPTH, 2, M_HEADS), f32)
    b_branch_gate = 0.1 * jax.random.normal(ks[5], (DEPTH, N_BRANCH * D_MODEL), f32)
    mlstm_norm_w = gain(ks[6], (DEPTH, M_WIDTH))
    lam_q1 = 0.1 * jax.random.normal(ks[7], (DEPTH, A_DH), f32)
    lam_k1 = 0.1 * jax.random.normal(ks[8], (DEPTH, A_DH), f32)
    lam_q2 = 0.1 * jax.random.normal(ks[9], (DEPTH, A_DH), f32)
    lam_k2 = 0.1 * jax.random.normal(ks[10], (DEPTH, A_DH), f32)
    attn_norm_w = gain(ks[11], (DEPTH, A_DV))
    w_branch_m = w(ks[12], (DEPTH, M_WIDTH, D_MODEL), M_WIDTH)
    w_branch_a = w(ks[13], (DEPTH, A_WIDTH, D_MODEL), A_WIDTH)
    w_out = w(ks[14], (DEPTH, D_MODEL, D_MODEL), D_MODEL)
    norm2_w = gain(ks[15], (DEPTH, D_MODEL))
    w_ffn_in = w(ks[16], (DEPTH, D_MODEL, 2 * D_FF), D_MODEL)
    w_ffn_out = w(ks[17], (DEPTH, D_FF, D_MODEL), D_FF)
    final_norm_w = gain(ks[18], (D_MODEL,))
    return {'x': x, 'norm1_w': norm1_w, 'w_in': w_in, 'b_igate': b_igate, 'b_fgate': b_fgate,
            'b_branch_gate': b_branch_gate, 'mlstm_norm_w': mlstm_norm_w,
            'lam_q1': lam_q1, 'lam_k1': lam_k1, 'lam_q2': lam_q2, 'lam_k2': lam_k2,
            'attn_norm_w': attn_norm_w, 'w_branch_m': w_branch_m, 'w_branch_a': w_branch_a,
            'w_out': w_out, 'norm2_w': norm2_w, 'w_ffn_in': w_ffn_in, 'w_ffn_out': w_ffn_out,
            'final_norm_w': final_norm_w}


def reference(x, norm1_w, w_in, b_igate, b_fgate, b_branch_gate, mlstm_norm_w,
              lam_q1, lam_k1, lam_q2, lam_k2, attn_norm_w, w_branch_m, w_branch_a,
              w_out, norm2_w, w_ffn_in, w_ffn_out, final_norm_w):
    B, S, D = x.shape
    for l in range(DEPTH):
        h = _rmsnorm(x, norm1_w[l])
        proj = h @ w_in[l]
        mq, mk, mv, mo, mg, aq, ak, av, gt = jnp.split(proj, IN_OFFSETS, axis=-1)

        q = mq.reshape(B, S, M_HEADS, M_DQK).transpose(0, 2, 1, 3)
        k = mk.reshape(B, S, M_HEADS, M_DQK).transpose(0, 2, 1, 3) * (M_DQK ** -0.5)
        v = mv.reshape(B, S, M_HEADS, M_DV).transpose(0, 2, 1, 3)
        g = mg.astype(jnp.float32).reshape(B, S, 2, 2, M_HEADS)
        ig = _softcap(g[:, :, :, 0] + b_igate[l].astype(jnp.float32))
        lf = jax.nn.log_sigmoid(_softcap(g[:, :, :, 1] + b_fgate[l].astype(jnp.float32)))
        ig = ig.transpose(2, 0, 3, 1)
        lf = lf.transpose(2, 0, 3, 1)
        h_fwd = _mlstm_scan(q, k, v, ig[0], lf[0])
        h_bwd = jnp.flip(_mlstm_scan(jnp.flip(q, 2), jnp.flip(k, 2), jnp.flip(v, 2),
                                     jnp.flip(ig[1], 2), jnp.flip(lf[1], 2)), 2)
        hm = (h_fwd + h_bwd).astype(x.dtype).transpose(0, 2, 1, 3)
        hm = _rmsnorm(hm, mlstm_norm_w[l].reshape(M_HEADS, M_DV))
        hm = hm * jax.nn.sigmoid(mo).reshape(B, S, M_HEADS, M_DV)
        branch_m = hm.reshape(B, S, M_WIDTH) @ w_branch_m[l]

        lam_init = 0.8 - 0.6 * math.exp(-0.3 * l)
        lam = (jnp.exp(jnp.dot(lam_q1[l].astype(jnp.float32), lam_k1[l].astype(jnp.float32)))
               - jnp.exp(jnp.dot(lam_q2[l].astype(jnp.float32), lam_k2[l].astype(jnp.float32)))
               + lam_init)
        qa = _rope(aq.reshape(B, S, A_HEADS, 2, A_DH))
        ka = _rope(ak.reshape(B, S, A_HEADS, 2, A_DH))
        va = av.reshape(B, S, A_HEADS, A_DV)
        ha = _diff_attention(qa, ka, va, lam)
        ha = _rmsnorm(ha, attn_norm_w[l]) * (1.0 - lam_init)
        branch_a = ha.reshape(B, S, A_WIDTH) @ w_branch_a[l]

        gates = jax.nn.sigmoid(gt + b_branch_gate[l])
        g_m, g_a = jnp.split(gates, N_BRANCH, axis=-1)
        x = x + (g_m * branch_m + g_a * branch_a) @ w_out[l]

        h2 = _rmsnorm(x, norm2_w[l])
        gate, up = jnp.split(h2 @ w_ffn_in[l], 2, axis=-1)
        x = x + (jax.nn.silu(gate) * up) @ w_ffn_out[l]
    return _rmsnorm(x, final_norm_w)
```

```cpp
#include <hip/hip_runtime.h>
#include <hip/hip_cooperative_groups.h>
#include <cstdio>
namespace cg = cooperative_groups;
namespace pg8 {
#define PG8_LAS __attribute__((address_space(3)))
typedef unsigned short bf16_t;
typedef short bf16x8 __attribute__((ext_vector_type(8)));
typedef float f32x4 __attribute__((ext_vector_type(4)));
typedef unsigned u32x4 __attribute__((ext_vector_type(4)));
constexpr int BM = 256, BK = 64, HALF = 128, HTB = HALF * BK * 2  , STAGE_BYTES = 8 * HTB, NXCD = 8, WGM = 8;

__host__ __device__ __forceinline__ int lds_byte(int r, int c) { const int st = (r >> 4) * 2 + (c >> 5), rr = r & 15, cc = c & 31, ob = rr * 64 + cc * 2; return st * 1024 + (ob ^ (((ob >> 9) & 1) << 5)); }
__host__ __device__ __forceinline__ void stage_rc(int b, int& R, int& C) { const int st = b / 1024, sb = b % 1024, swz = sb ^ (((sb >> 9) & 1) << 5); R = (st >> 1) * 16 + swz / 64; C = (st & 1) * 32 + (swz % 64) / 2; }
__host__ __device__ __forceinline__ int perm32(int rho) { const int n = rho >> 4, i = rho & 15; return 8 * (i >> 2) + 4 * n + (i & 3); }

struct Unit { int pm, pn; };
struct Gemm { const bf16_t* A; const bf16_t* Bt; int M, N, K; };

struct StaticOrder {
    int nM, nN, nwg, G, c;
    __host__ __device__ void init(int M, int N, int G_, int c_) { nM = M / BM; nN = N / BM; nwg = nM * nN; G = G_; c = c_; }
    __host__ __device__ bool next(int i, Unit& u) const {
        const long L = (long)i * G + c; if (L >= nwg) return false;
        int wgid = (int)L; { const int q = nwg / NXCD, r = nwg % NXCD, xcd = wgid % NXCD, off = wgid / NXCD; wgid = (xcd < r ? xcd * (q + 1) : r * (q + 1) + (xcd - r) * q) + off; }
        const int nig = WGM * nN, gid = wgid / nig, fm = gid * WGM, gsz = (nM - fm) < WGM ? (nM - fm) : WGM;
        u.pm = fm + ((wgid % nig) % gsz); u.pn = (wgid % nig) / gsz; return true;
    }
    __device__ __forceinline__ void a_ready(const Unit&) const {}
    __device__ __forceinline__ void done(const Unit&) const {}
};
__device__ __forceinline__ unsigned cvt_pk_bf16(float lo, float hi) { unsigned r; asm volatile("v_cvt_pk_bf16_f32 %0, %1, %2" : "=v"(r) : "v"(lo), "v"(hi)); return r; }
typedef float f32x2 __attribute__((ext_vector_type(2)));
template <class Epi, class Sched, bool STAMP = false>
__device__ __forceinline__ void gemm_phase(PG8_LAS unsigned char* lds, const Gemm g, const Sched& S, const Epi& E, unsigned long long* stamps) {
    int tid_ = threadIdx.x; asm volatile("" : "+v"(tid_));
    const int tid = tid_, wid = __builtin_amdgcn_readfirstlane(tid >> 6), lane = tid & 63, wr = wid >> 2, wc = wid & 3, fr = lane & 15, fq = lane >> 4;
    const int K = g.K, nt = K / BK;
    int ts_lo = 0, ts_hi = 0, nts = 0; const unsigned long long rt_entry = STAMP ? (unsigned long long)wall_clock64() : 0ull;
#define PG8_STAMP() do { if (STAMP && wid == 0 && nts < 64) { const unsigned long long _c = (unsigned long long)clock64(); \
        ts_lo = (lane == nts) ? (int)(unsigned)_c : ts_lo; ts_hi = (lane == nts) ? (int)(unsigned)(_c >> 32) : ts_hi; ++nts; } } while (0)
    PG8_STAMP();
    unsigned voffA[2], voffB[2];
#pragma unroll
    for (int i = 0; i < 2; ++i) { int R, C; stage_rc(tid * 16 + i * 8192, R, C); const int Rb = Epi::PERM ? ((R & ~31) + perm32(R & 31)) : R;
        voffA[i] = (unsigned)(R * K + C) * 2u; voffB[i] = (unsigned)(Rb * K + C) * 2u; }
    const size_t kstep = (size_t)(BK * 2);
    const size_t hstep = (size_t)HALF * K * 2;
    const size_t tstep = 2 * hstep;
    const unsigned ldsw = (unsigned)wid * 1024u;
    const int aoff = lds_byte(wr * 64 + fr, fq * 8), boff = lds_byte(wc * 32 + fr, fq * 8);
#define PG8_SA(b, h) (((b) * 2 + (h)) * HTB)
#define PG8_SB(b, h) ((4 + (b) * 2 + (h)) * HTB)
#define PG8_STAGE(bufoff, gbase, voff) do { _Pragma("unroll") for (int _i = 0; _i < 2; ++_i) \
        __builtin_amdgcn_global_load_lds((const unsigned*)((const char*)(gbase) + (voff)[_i]), (PG8_LAS unsigned*)(lds + (bufoff) + ldsw + _i * 8192), 16, 0, 0); } while (0)
#define PG8_LDA(dst, b, h) do { _Pragma("unroll") for (int m = 0; m < 4; ++m) _Pragma("unroll") for (int k = 0; k < 2; ++k) dst[m][k] = *(const PG8_LAS bf16x8*)(lds + PG8_SA(b, h) + aoff + m * 2048 + k * 1024); } while (0)
#define PG8_LDB(dst, b, h) do { _Pragma("unroll") for (int n = 0; n < 2; ++n) _Pragma("unroll") for (int k = 0; k < 2; ++k) dst[n][k] = *(const PG8_LAS bf16x8*)(lds + PG8_SB(b, h) + boff + n * 2048 + k * 1024); } while (0)
#define PG8_MMA(ai, bj, At, Bt) do { __builtin_amdgcn_s_setprio(1); _Pragma("unroll") for (int m = 0; m < 4; ++m) _Pragma("unroll") for (int n = 0; n < 2; ++n) _Pragma("unroll") for (int k = 0; k < 2; ++k) \
        acc[ai][bj][m][n] = __builtin_amdgcn_mfma_f32_16x16x32_bf16(Bt[n][k], At[m][k], acc[ai][bj][m][n], 0, 0, 0); __builtin_amdgcn_s_setprio(0); } while (0)
#define PG8_WAIT_V(n) asm volatile("s_waitcnt vmcnt(" #n ")" ::: "memory")
#define PG8_WAIT_L(n) asm volatile("s_waitcnt lgkmcnt(" #n ")" ::: "memory")
#define PG8_BAR __builtin_amdgcn_s_barrier()
#define PG8_SCHED __builtin_amdgcn_sched_barrier(0)
    Unit cur, nxt; int ui = 0;
    if (!S.next(0, cur)) return;
    f32x4 acc[2][2][4][2];
#pragma unroll
    for (int a = 0; a < 2; ++a)
#pragma unroll
        for (int b = 0; b < 2; ++b)
#pragma unroll
            for (int m = 0; m < 4; ++m)
#pragma unroll
                for (int n = 0; n < 2; ++n) acc[a][b][m][n] = (f32x4){0.f, 0.f, 0.f, 0.f};
    bf16x8 At[4][2], B0[2][2], B1[2][2];
    const char* cA = (const char*)g.A + (size_t)cur.pm * tstep; const char* cB = (const char*)g.Bt + (size_t)cur.pn * tstep;
    S.a_ready(cur);
    PG8_STAGE(PG8_SB(0, 0), cB, voffB); PG8_STAGE(PG8_SA(0, 0), cA, voffA); PG8_STAGE(PG8_SB(0, 1), cB + hstep, voffB); PG8_STAGE(PG8_SA(0, 1), cA + hstep, voffA);
    if (wr == 1) PG8_BAR;
    PG8_WAIT_V(4); PG8_BAR;
    PG8_STAGE(PG8_SB(1, 0), cB + kstep, voffB); PG8_STAGE(PG8_SA(1, 0), cA + kstep, voffA); PG8_STAGE(PG8_SB(1, 1), cB + hstep + kstep, voffB);
    PG8_WAIT_V(6); PG8_BAR;
    PG8_STAMP();
    for (;;) {
        const bool has_next = S.next(ui + 1, nxt);
        const char* nA = has_next ? (const char*)g.A + (size_t)nxt.pm * tstep : cA; const char* nB = has_next ? (const char*)g.Bt + (size_t)nxt.pn * tstep : cB;
        for (int t = 0; t < nt; t += 2) {
            const bool last = (t == nt - 2);
            const char* a1 = cA + (size_t)(t + 1) * kstep;
            const char* a2 = last ? nA : cA + (size_t)(t + 2) * kstep; const char* b2 = last ? nB : cB + (size_t)(t + 2) * kstep;
            const char* a3 = a2 + kstep; const char* b3 = b2 + kstep;
            if (last && has_next) S.a_ready(nxt);
            PG8_LDB(B0, 0, 0); PG8_SCHED; PG8_LDA(At, 0, 0); PG8_STAGE(PG8_SA(1, 1), a1 + hstep, voffA);
            PG8_WAIT_L(8); PG8_BAR; PG8_WAIT_L(0); PG8_MMA(0, 0, At, B0); PG8_BAR; PG8_SCHED;
            PG8_LDB(B1, 0, 1); PG8_STAGE(PG8_SB(0, 0), b2, voffB);
            PG8_BAR; PG8_WAIT_L(0); PG8_MMA(0, 1, At, B1); PG8_BAR;
            PG8_LDA(At, 0, 1); PG8_STAGE(PG8_SA(0, 0), a2, voffA);
            PG8_BAR; PG8_WAIT_L(0); PG8_MMA(1, 0, At, B0); PG8_BAR; PG8_SCHED;
            PG8_STAGE(PG8_SB(0, 1), b2 + hstep, voffB);
            PG8_WAIT_V(6); PG8_BAR; PG8_MMA(1, 1, At, B1); PG8_BAR;
            PG8_LDB(B0, 1, 0); PG8_SCHED; PG8_LDA(At, 1, 0); PG8_STAGE(PG8_SA(0, 1), a2 + hstep, voffA);
            PG8_WAIT_L(8); PG8_BAR; PG8_WAIT_L(0); PG8_MMA(0, 0, At, B0); PG8_BAR; PG8_SCHED;
            PG8_LDB(B1, 1, 1); PG8_STAGE(PG8_SB(1, 0), b3, voffB);
            PG8_BAR; PG8_WAIT_L(0); PG8_MMA(0, 1, At, B1); PG8_BAR;
            PG8_LDA(At, 1, 1); PG8_STAGE(PG8_SA(1, 0), a3, voffA);
            PG8_BAR; PG8_WAIT_L(0); PG8_MMA(1, 0, At, B0); PG8_BAR; PG8_SCHED;
            PG8_STAGE(PG8_SB(1, 1), b3 + hstep, voffB);
            PG8_WAIT_V(6); PG8_BAR; PG8_MMA(1, 1, At, B1); PG8_BAR;
        }
        PG8_STAMP();
        if constexpr (!Epi::AFTER_DRAIN) { E(acc, cur, wr, wc, fr, fq); S.done(cur); }
        PG8_STAMP();
        if (!has_next) break;
#pragma unroll
        for (int a = 0; a < 2; ++a)
#pragma unroll
            for (int b = 0; b < 2; ++b)
#pragma unroll
                for (int m = 0; m < 4; ++m)
#pragma unroll
                    for (int n = 0; n < 2; ++n) acc[a][b][m][n] = (f32x4){0.f, 0.f, 0.f, 0.f};
        cur = nxt; cA = nA; cB = nB; ++ui;
    }
    PG8_WAIT_V(0);
    if (wr == 0) PG8_BAR;
    PG8_BAR;
    if constexpr (Epi::AFTER_DRAIN) { E.fused(acc, cur, wr, wc, fr, fq, lds, wid, lane); S.done(cur); }
    PG8_STAMP();
    if (STAMP && wid == 0) { stamps[lane] = lane < nts ? (((unsigned long long)(unsigned)ts_hi << 32) | (unsigned)ts_lo) : 0ull;
        if (lane == 62) stamps[62] = rt_entry; if (lane == 63) stamps[63] = (unsigned long long)wall_clock64(); }
#undef PG8_STAMP
#undef PG8_SA
#undef PG8_SB
#undef PG8_STAGE
#undef PG8_LDA
#undef PG8_LDB
#undef PG8_MMA
#undef PG8_WAIT_V
#undef PG8_WAIT_L
#undef PG8_BAR
#undef PG8_SCHED
}
}

using pg8::bf16_t; using pg8::bf16x8; using pg8::f32x4; using pg8::u32x4;
typedef float f32x16 __attribute__((ext_vector_type(16)));
typedef float f32x2v __attribute__((ext_vector_type(2)));
typedef unsigned u32x2 __attribute__((ext_vector_type(2)));
typedef __bf16 bf16v2 __attribute__((ext_vector_type(2)));
#ifndef SKIP_P0
#define SKIP_P0 0
#endif
#ifndef SKIP_P1
#define SKIP_P1 0
#endif
#ifndef SKIP_P2
#define SKIP_P2 0
#endif
#ifndef SKIP_P3
#define SKIP_P3 0
#endif
#ifndef SKIP_P4
#define SKIP_P4 0
#endif
#ifndef SKIP_P5
#define SKIP_P5 0
#endif
#ifndef SKIP_P6
#define SKIP_P6 0
#endif
#ifndef SKIP_P7
#define SKIP_P7 0
#endif
#ifndef SKIP_P8
#define SKIP_P8 0
#endif
#ifndef SKIP_P9
#define SKIP_P9 0
#endif
#define LAS __attribute__((address_space(3)))
#define DI __device__ __forceinline__

constexpr int T_ = 32768, D_ = 2048, S_ = 8192, DFF_ = 5632, DIN_ = 10256, PLD = 8192;
constexpr size_t MIB = (size_t)1 << 20;
constexpr size_t WS_W1T = 0, WS_W2T = 32 * MIB, WS_WBM = 42 * MIB, WS_WBA = 46 * MIB, WS_WOUT = 50 * MIB, WS_WFFI = 58 * MIB, WS_WFFO = 102 * MIB;
constexpr size_t WS_RA = 128 * MIB, WS_PROJ = 256 * MIB, WS_XT = 768 * MIB, WS_SMALL = 928 * MIB;
constexpr size_t WS_G16 = WS_SMALL, WS_BC = WS_SMALL + 2 * MIB, WS_U = WS_SMALL + 3 * MIB, WS_PM = WS_SMALL + 4 * MIB, WS_COS = WS_SMALL + 5 * MIB, WS_SIN = WS_SMALL + 6 * MIB, WS_MISC = WS_SMALL + 7 * MIB;
constexpr int LDS_STAGE = 131072, LDS_BYTES = LDS_STAGE + 1024;
constexpr float EPS_ = 1e-6f;
constexpr float KSCALE = 0.08838834764831845f;
constexpr float QSCALE = 0.125f * 1.4426950408889634f;
constexpr int N_MLSTM_ITEMS = 128, N_ATTN_ITEMS = 2048;

struct Params { const float* in[19]; float* out; unsigned char* ws; };
__device__ __forceinline__ unsigned long long karg64(int off) { unsigned long long r; asm volatile("s_load_dwordx2 %0, %1, %2\n\ts_waitcnt lgkmcnt(0)" : "=s"(r) : "s"(__builtin_amdgcn_kernarg_segment_ptr()), "n"(off)); return r; }
__device__ __forceinline__ unsigned long long karg64d(int off) { unsigned long long r; asm volatile("s_load_dwordx2 %0, %1, %2\n\ts_waitcnt lgkmcnt(0)" : "=s"(r) : "s"(__builtin_amdgcn_kernarg_segment_ptr()), "s"(__builtin_amdgcn_readfirstlane(off))); return r; }
#define KIN(i) ((const float*)karg64(8 * (i)))
#define KOUT ((float*)karg64(152))
#define KWS ((unsigned char*)karg64(160))

__constant__ float c_inv[32] = {1.000000000e+00f, 7.498942614e-01f, 5.623413324e-01f, 4.216965139e-01f, 3.162277639e-01f, 2.371373773e-01f, 1.778279394e-01f, 1.333521307e-01f, 1.000000015e-01f, 7.498941571e-02f, 5.623413250e-02f, 4.216965288e-02f, 3.162277490e-02f, 2.371373773e-02f, 1.778279431e-02f, 1.333521493e-02f, 9.999999776e-03f, 7.498941850e-03f, 5.623413250e-03f, 4.216964822e-03f, 3.162277630e-03f, 2.371373586e-03f, 1.778279431e-03f, 1.333521446e-03f, 1.000000047e-03f, 7.498942432e-04f, 5.623413017e-04f, 4.216965172e-04f, 3.162277571e-04f, 2.371373703e-04f, 1.778279402e-04f, 1.333521504e-04f};

struct ConvReg { int src, ld, K, ngroups, kind, col0; unsigned long long dst; float scale; int pad; };
constexpr int NREG = 14;
__constant__ ConvReg c_regs[NREG] = {
    {2, DIN_, 2048, 8, 0, 0, WS_W1T, 1.0f, 0},
    {2, DIN_, 2048, 8, 0, 512, WS_W1T + 512ull * 4096, KSCALE, 0},
    {2, DIN_, 2048, 16, 0, 2048, WS_W1T + 1024ull * 4096, 1.0f, 0},
    {2, DIN_, 2048, 16, 1, 3088, WS_W1T + 2048ull * 4096, QSCALE, 0},
    {2, DIN_, 2048, 16, 1, 4112, WS_W1T + 3072ull * 4096, 1.0f, 0},
    {2, DIN_, 2048, 64, 0, 6160, WS_W1T + 4096ull * 4096, 1.0f, 0},
    {2, DIN_, 2048, 8, 0, 512, WS_W2T, KSCALE, 0},
    {2, DIN_, 2048, 16, 0, 1024, WS_W2T + 512ull * 4096, 1.0f, 0},
    {2, DIN_, 2048, 16, 0, 5136, WS_W2T + 1536ull * 4096, 1.0f, 0},
    {12, 2048, 1024, 32, 0, 0, WS_WBM, 1.0f, 0},
    {13, 2048, 1024, 32, 0, 0, WS_WBA, 1.0f, 0},
    {14, 2048, 2048, 32, 0, 0, WS_WOUT, 1.0f, 0},
    {16, 2 * DFF_, 2048, 176, 2, 0, WS_WFFI, 1.0f, 0},
    {17, 2048, DFF_, 32, 0, 0, WS_WFFO, 1.0f, 0}};

DI unsigned short f2bf(float f) { unsigned u = __float_as_uint(f); u += 0x7fffu + ((u >> 16) & 1u); return (unsigned short)(u >> 16); }
DI float bf2f(unsigned short b) { return __uint_as_float(((unsigned)b) << 16); }
DI float bflo(unsigned w) { return __uint_as_float(w << 16); }
DI float bfhi(unsigned w) { return __uint_as_float(w & 0xffff0000u); }
DI unsigned pk2(float lo, float hi) { f32x2v v = {lo, hi}; bf16v2 r = __builtin_convertvector(v, bf16v2); return __builtin_bit_cast(unsigned, r); }
DI bf16x8 pack8(float a0, float a1, float a2, float a3, float a4, float a5, float a6, float a7) { u32x4 p; p.x = pk2(a0, a1); p.y = pk2(a2, a3); p.z = pk2(a4, a5); p.w = pk2(a6, a7); return __builtin_bit_cast(bf16x8, p); }
DI float sigmoidf_(float x) { return __builtin_amdgcn_rcpf(1.0f + __expf(-x)); }
DI float wave_sum(float v) { for (int o = 32; o >= 1; o >>= 1) v += __shfl_xor(v, o); return v; }
DI int fresh_tid() { int t = threadIdx.x; asm volatile("" : "+v"(t)); return t; }
#define MFMA16(a, b, c) __builtin_amdgcn_mfma_f32_16x16x32_bf16((a), (b), (c), 0, 0, 0)
#define MFMA32(a, b, c) __builtin_amdgcn_mfma_f32_32x32x16_bf16((a), (b), (c), 0, 0, 0)

DI void conv_unit(int u, LAS float* tile, int tid) {
    int ri = 0, lu = u;
    for (; ri < NREG - 1; ++ri) { const int n = c_regs[ri].ngroups * (c_regs[ri].K >> 6); if (lu < n) break; lu -= n; }
    struct { int src, ld, K, kind, col0; unsigned long long dst; float scale; } R = {c_regs[ri].src, c_regs[ri].ld, c_regs[ri].K, c_regs[ri].kind, c_regs[ri].col0, c_regs[ri].dst, c_regs[ri].scale};
    const int nK = R.K >> 6, g = lu / nK, kt = lu - g * nK;
    int cbase;
    if (R.kind == 2) { const int pn = g >> 2, q = g & 3; cbase = (q < 2) ? (128 * pn + 64 * q) : (DFF_ + 128 * pn + 64 * (q - 2)); }
    else cbase = R.col0 + 64 * g;
    const float* src = ((const float*)karg64d(8 * R.src)) + (size_t)(64 * kt) * R.ld + cbase; unsigned char* const wsp = KWS;
    {
        const int col = tid & 63, kr0 = tid >> 6;
#pragma unroll
        for (int i = 0; i < 8; ++i) { const int kr = kr0 + 8 * i; tile[kr * 65 + col] = src[(size_t)kr * R.ld + col] * R.scale; }
    }
    __syncthreads();
    {
        const int rr = tid >> 3, ks = (tid & 7) * 8;
        const int sc = (R.kind == 1) ? ((rr & 1) ? (rr >> 1) + 32 : (rr >> 1)) : rr;
        float v[8];
#pragma unroll
        for (int j = 0; j < 8; ++j) v[j] = tile[(ks + j) * 65 + sc];
        bf16_t* dst = (bf16_t*)(wsp + R.dst) + (size_t)(64 * g + rr) * R.K + 64 * kt + ks;
        *(bf16x8*)dst = pack8(v[0], v[1], v[2], v[3], v[4], v[5], v[6], v[7]);
    }
    __syncthreads();
}

DI void p0_norm_gates(LAS float* Wg, int tid) {
    const float* x = KIN(0); const float* n1 = KIN(1); const float* w_in = KIN(2);
    for (int e = tid; e < 16 * 2048; e += 512) { const int k = e >> 4, j = e & 15; Wg[j * 2048 + k] = w_in[(size_t)k * DIN_ + 3072 + j] * n1[k]; }
    __syncthreads();
    const int lane = tid & 63, w = tid >> 6;
    unsigned char* const wsp = KWS; bf16_t* H = (bf16_t*)(wsp + WS_RA); float* G16 = (float*)(wsp + WS_G16);
    const int nw = gridDim.x * 8;
    for (int pr = blockIdx.x * 8 + w; pr < T_ / 2; pr += nw) {
        const float* xa = x + (size_t)(2 * pr) * D_; const float* xb = xa + D_;
        float sa = 0.f, sb = 0.f;
        float ga[16], gb[16];
#pragma unroll
        for (int j = 0; j < 16; ++j) { ga[j] = 0.f; gb[j] = 0.f; }
#pragma unroll 1
        for (int i = 0; i < 8; ++i) {
            const f32x4 va = *(const f32x4*)(xa + 4 * lane + 256 * i), vb = *(const f32x4*)(xb + 4 * lane + 256 * i);
            sa += va[0] * va[0] + va[1] * va[1] + va[2] * va[2] + va[3] * va[3]; sb += vb[0] * vb[0] + vb[1] * vb[1] + vb[2] * vb[2] + vb[3] * vb[3];
#pragma unroll
            for (int j = 0; j < 16; ++j) { const f32x4 wv = *(const LAS f32x4*)(Wg + j * 2048 + 4 * lane + 256 * i);
                ga[j] += va[0] * wv[0] + va[1] * wv[1] + va[2] * wv[2] + va[3] * wv[3];
                gb[j] += vb[0] * wv[0] + vb[1] * wv[1] + vb[2] * wv[2] + vb[3] * wv[3]; }
        }
        sa = wave_sum(sa); sb = wave_sum(sb);
        const float ra = rsqrtf(sa * (1.0f / D_) + EPS_), rb = rsqrtf(sb * (1.0f / D_) + EPS_);
        float oa = 0.f, ob = 0.f;
#pragma unroll
        for (int j = 0; j < 16; ++j) { const float ta = wave_sum(ga[j]), tb = wave_sum(gb[j]); if (lane == j) { oa = ta; ob = tb; } }
        if (lane < 16) { G16[(size_t)(2 * pr) * 16 + lane] = oa * ra; G16[(size_t)(2 * pr + 1) * 16 + lane] = ob * rb; }
#pragma unroll 2
        for (int i = 0; i < 8; ++i) { const f32x4 nw4 = *(const f32x4*)(n1 + 4 * lane + 256 * i);
            const f32x4 va = *(const f32x4*)(xa + 4 * lane + 256 * i), vb = *(const f32x4*)(xb + 4 * lane + 256 * i);
            u32x2 oa2, ob2;
            oa2.x = pk2(va[0] * ra * nw4[0], va[1] * ra * nw4[1]); oa2.y = pk2(va[2] * ra * nw4[2], va[3] * ra * nw4[3]);
            ob2.x = pk2(vb[0] * rb * nw4[0], vb[1] * rb * nw4[1]); ob2.y = pk2(vb[2] * rb * nw4[2], vb[3] * rb * nw4[3]);
            *(u32x2*)(H + (size_t)(2 * pr) * D_ + 4 * lane + 256 * i) = oa2; *(u32x2*)(H + (size_t)(2 * pr + 1) * D_ + 4 * lane + 256 * i) = ob2; }
    }
}

template <bool TO_BF16>
DI void rows_rmsnorm(const float* X, const float* wgt, bf16_t* Ob, float* Of, int tid) {
    const int lane = tid & 63, w = tid >> 6; const int nw = gridDim.x * 8;
    for (int t = blockIdx.x * 8 + w; t < T_; t += nw) {
        const float* xr = X + (size_t)t * D_;
        f32x4 v[8]; float s = 0.f;
#pragma unroll
        for (int i = 0; i < 8; ++i) { v[i] = *(const f32x4*)(xr + 4 * lane + 256 * i); s += v[i][0] * v[i][0] + v[i][1] * v[i][1] + v[i][2] * v[i][2] + v[i][3] * v[i][3]; }
        s = wave_sum(s); const float r = rsqrtf(s * (1.0f / D_) + EPS_);
#pragma unroll
        for (int i = 0; i < 8; ++i) { const f32x4 g = *(const f32x4*)(wgt + 4 * lane + 256 * i);
            if (TO_BF16) { u32x2 o; o.x = pk2(v[i][0] * r * g[0], v[i][1] * r * g[1]); o.y = pk2(v[i][2] * r * g[2], v[i][3] * r * g[3]); *(u32x2*)(Ob + (size_t)t * D_ + 4 * lane + 256 * i) = o; }
            else { f32x4 o; o[0] = v[i][0] * r * g[0]; o[1] = v[i][1] * r * g[1]; o[2] = v[i][2] * r * g[2]; o[3] = v[i][3] * r * g[3]; *(f32x4*)(Of + (size_t)t * D_ + 4 * lane + 256 * i) = o; }
        }
    }
}

struct EpiMain {
    static constexpr bool PERM = true, AFTER_DRAIN = false;
    bf16_t* O; const float* gbias; const float* cosT; const float* sinT;
    DI void operator()(const f32x4 (&acc)[2][2][4][2], const pg8::Unit& u, int wr, int wc, int fr, int fq) const {
        const int row0 = u.pm * 256 + wr * 64 + fr, colb = u.pn * 256 + wc * 32 + 8 * fq;
        const int ty = (u.pn < 4) ? 0 : (u.pn < 8) ? 1 : (u.pn < 16) ? 2 : 3;
#pragma unroll
        for (int ai = 0; ai < 2; ++ai)
#pragma unroll
            for (int m = 0; m < 4; ++m) {
                const int row = row0 + ai * 128 + m * 16; bf16_t* rowp = O + (size_t)row * PLD + colb;
                f32x4 cs = {1.f, 1.f, 1.f, 1.f}, sn = {0.f, 0.f, 0.f, 0.f};
                if (ty == 2) { const int pos = row & (S_ - 1), j0 = 16 * (wc & 1) + 4 * fq; cs = *(const f32x4*)(cosT + pos * 32 + j0); sn = *(const f32x4*)(sinT + pos * 32 + j0); }
#pragma unroll
                for (int bj = 0; bj < 2; ++bj) {
                    f32x4 v0 = acc[ai][bj][m][0], v1 = acc[ai][bj][m][1];
                    if (ty == 1) {
#pragma unroll
                        for (int j = 0; j < 4; ++j) { v0[j] = sigmoidf_(v0[j]); v1[j] = sigmoidf_(v1[j]); }
                    } else if (ty == 2) {
                        f32x4 a, b;
                        a[0] = v0[0] * cs[0] - v0[1] * sn[0]; a[1] = v0[0] * sn[0] + v0[1] * cs[0];
                        a[2] = v0[2] * cs[1] - v0[3] * sn[1]; a[3] = v0[2] * sn[1] + v0[3] * cs[1];
                        b[0] = v1[0] * cs[2] - v1[1] * sn[2]; b[1] = v1[0] * sn[2] + v1[1] * cs[2];
                        b[2] = v1[2] * cs[3] - v1[3] * sn[3]; b[3] = v1[2] * sn[3] + v1[3] * cs[3];
                        v0 = a; v1 = b;
                    } else if (ty == 3) {
                        const float* bp = gbias + (colb + bj * 128 - 4096);
                        const f32x4 b0 = *(const f32x4*)bp, b1 = *(const f32x4*)(bp + 4);
#pragma unroll
                        for (int j = 0; j < 4; ++j) { v0[j] = sigmoidf_(v0[j] + b0[j]); v1[j] = sigmoidf_(v1[j] + b1[j]); }
                    }
                    u32x4 o; o.x = pk2(v0[0], v0[1]); o.y = pk2(v0[2], v0[3]); o.z = pk2(v1[0], v1[1]); o.w = pk2(v1[2], v1[3]);
                    *(u32x4*)(rowp + bj * 128) = o;
                }
            }
    }
};
struct EpiPlain {
    static constexpr bool PERM = true, AFTER_DRAIN = false;
    bf16_t* O; int ldc;
    DI void operator()(const f32x4 (&acc)[2][2][4][2], const pg8::Unit& u, int wr, int wc, int fr, int fq) const {
        const int row0 = u.pm * 256 + wr * 64 + fr, colb = u.pn * 256 + wc * 32 + 8 * fq;
#pragma unroll
        for (int ai = 0; ai < 2; ++ai)
#pragma unroll
            for (int m = 0; m < 4; ++m) { bf16_t* rowp = O + (size_t)(row0 + ai * 128 + m * 16) * ldc + colb;
#pragma unroll
                for (int bj = 0; bj < 2; ++bj) { const f32x4 v0 = acc[ai][bj][m][0], v1 = acc[ai][bj][m][1];
                    u32x4 o; o.x = pk2(v0[0], v0[1]); o.y = pk2(v0[2], v0[3]); o.z = pk2(v1[0], v1[1]); o.w = pk2(v1[2], v1[3]);
                    *(u32x4*)(rowp + bj * 128) = o; } }
    }
};
template <int SECOND> struct EpiBranch {
    static constexpr bool PERM = true, AFTER_DRAIN = false;
    const bf16_t* proj; bf16_t* tmp; bf16_t* mg;
    DI void operator()(const f32x4 (&acc)[2][2][4][2], const pg8::Unit& u, int wr, int wc, int fr, int fq) const {
        const int row0 = u.pm * 256 + wr * 64 + fr, colb = u.pn * 256 + wc * 32 + 8 * fq;
#pragma unroll
        for (int ai = 0; ai < 2; ++ai)
#pragma unroll
            for (int m = 0; m < 4; ++m) { const int row = row0 + ai * 128 + m * 16;
#pragma unroll
                for (int bj = 0; bj < 2; ++bj) { const int col = colb + bj * 128;
                    const u32x4 g = *(const u32x4*)(proj + (size_t)row * PLD + 4096 + 2048 * SECOND + col);
                    const f32x4 v0 = acc[ai][bj][m][0], v1 = acc[ai][bj][m][1];
                    float r[8] = {v0[0] * bflo(g.x), v0[1] * bfhi(g.x), v0[2] * bflo(g.y), v0[3] * bfhi(g.y), v1[0] * bflo(g.z), v1[1] * bfhi(g.z), v1[2] * bflo(g.w), v1[3] * bfhi(g.w)};
                    if (SECOND) { const u32x4 t = *(const u32x4*)(tmp + (size_t)row * D_ + col);
                        r[0] += bflo(t.x); r[1] += bfhi(t.x); r[2] += bflo(t.y); r[3] += bfhi(t.y); r[4] += bflo(t.z); r[5] += bfhi(t.z); r[6] += bflo(t.w); r[7] += bfhi(t.w); }
                    u32x4 o; o.x = pk2(r[0], r[1]); o.y = pk2(r[2], r[3]); o.z = pk2(r[4], r[5]); o.w = pk2(r[6], r[7]);
                    *(u32x4*)((SECOND ? mg : tmp) + (size_t)row * D_ + col) = o; } }
    }
};
struct EpiResid {
    static constexpr bool PERM = false, AFTER_DRAIN = false;
    const float* base; float* out;
    DI void operator()(const f32x4 (&acc)[2][2][4][2], const pg8::Unit& u, int wr, int wc, int fr, int fq) const {
        const int row0 = u.pm * 256 + wr * 64 + fr, col0 = u.pn * 256 + wc * 32 + 4 * fq;
#pragma unroll
        for (int ai = 0; ai < 2; ++ai)
#pragma unroll
            for (int m = 0; m < 4; ++m) { const size_t off = (size_t)(row0 + ai * 128 + m * 16) * D_ + col0;
#pragma unroll
                for (int bj = 0; bj < 2; ++bj)
#pragma unroll
                    for (int n = 0; n < 2; ++n) { const f32x4 b = *(const f32x4*)(base + off + bj * 128 + n * 16); *(f32x4*)(out + off + bj * 128 + n * 16) = b + acc[ai][bj][m][n]; } }
    }
};
struct EpiSwiglu {
    static constexpr bool PERM = true, AFTER_DRAIN = false;
    bf16_t* act;
    DI void operator()(const f32x4 (&acc)[2][2][4][2], const pg8::Unit& u, int wr, int wc, int fr, int fq) const {
        const int row0 = u.pm * 256 + wr * 64 + fr, col = u.pn * 128 + wc * 32 + 8 * fq;
#pragma unroll
        for (int ai = 0; ai < 2; ++ai)
#pragma unroll
            for (int m = 0; m < 4; ++m) { const int row = row0 + ai * 128 + m * 16;
                float r[8];
#pragma unroll
                for (int n = 0; n < 2; ++n)
#pragma unroll
                    for (int j = 0; j < 4; ++j) { const float g = acc[ai][0][m][n][j], up = acc[ai][1][m][n][j]; r[4 * n + j] = g * sigmoidf_(g) * up; }
                u32x4 o; o.x = pk2(r[0], r[1]); o.y = pk2(r[2], r[3]); o.z = pk2(r[4], r[5]); o.w = pk2(r[6], r[7]);
                *(u32x4*)(act + (size_t)row * DFF_ + col) = o; }
    }
};

DI void gate_prep(int tid) {
    const int lane = tid & 63, w = tid >> 6; const int nw = gridDim.x * 8;
    unsigned char* const wsp = KWS; const float* bigate = KIN(3); const float* bfgate = KIN(4);
    const float* G16 = (const float*)(wsp + WS_G16);
    float* BC = (float*)(wsp + WS_BC); float* U = (float*)(wsp + WS_U); float* PM = (float*)(wsp + WS_PM);
    for (int id = blockIdx.x * 8 + w; id < 32 * 64; id += nw) {
        const int stream = id >> 6, pc = id & 63; const int dir = stream >> 4, b = (stream >> 2) & 3, h = stream & 3;
        const float bi = bigate[dir * 4 + h], bfg = bfgate[dir * 4 + h];
        float lf[2], ig[2];
#pragma unroll
        for (int e = 0; e < 2; ++e) { const int i = 2 * lane + e; const int p = dir ? 127 - i : i; const size_t tok = (size_t)b * S_ + pc * 128 + p;
            const float gi = G16[tok * 16 + dir * 8 + h] + bi, gf = G16[tok * 16 + dir * 8 + 4 + h] + bfg;
            ig[e] = 15.0f * tanhf(gi * (1.0f / 15.0f));
            const float fc = 15.0f * tanhf(gf * (1.0f / 15.0f));
            lf[e] = fminf(fc, 0.f) - log1pf(expf(-fabsf(fc))); }
        float s = lf[0] + lf[1];
#pragma unroll
        for (int o = 1; o < 64; o <<= 1) { const float t = __shfl_up(s, o); if (lane >= o) s += t; }
        const float b1 = s, b0 = s - lf[1];
        const float u0 = ig[0] - b0, u1 = ig[1] - b1;
        float mx = fmaxf(u0, u1);
#pragma unroll
        for (int o = 1; o < 64; o <<= 1) { const float t = __shfl_up(mx, o); if (lane >= o) mx = fmaxf(mx, t); }
        float mprev = __shfl_up(mx, 1); if (lane == 0) mprev = -INFINITY;
        const float pm0 = fmaxf(mprev, u0), pm1 = mx;
        const size_t base = (size_t)stream * S_ + pc * 128;
        const int p0 = dir ? 127 - 2 * lane : 2 * lane, p1 = dir ? 126 - 2 * lane : 2 * lane + 1;
        BC[base + p0] = b0; BC[base + p1] = b1; U[base + p0] = u0; U[base + p1] = u1; PM[base + p0] = pm0; PM[base + p1] = pm1;
    }
}

DI void mlstm_item(int item, LAS unsigned char* lds, int tid) {
    const int lane = tid & 63, w = tid >> 6, fr = lane & 15, fq = lane >> 4;
    const int vs = item & 3, h = (item >> 2) & 3, b = (item >> 4) & 3, dir = item >> 6;
    const int stream = dir * 16 + b * 4 + h;
    constexpr int LD = 136;
    LAS bf16_t* Ks = (LAS bf16_t*)lds; LAS bf16_t* KTs = Ks + 128 * LD; LAS bf16_t* VTs = KTs + 128 * LD; LAS bf16_t* VTw = VTs + 64 * LD; LAS bf16_t* Cs = VTw + 64 * LD;
    LAS float* su = (LAS float*)(Cs + 64 * LD); LAS float* spm = su + 128; LAS float* sbc = su + 256; LAS float* swk = su + 384; LAS float* snl = su + 512;
    for (int e = tid; e < 64 * LD / 2; e += 512) ((LAS unsigned*)Cs)[e] = 0u;
    if (tid < 128) snl[tid] = 0.f;
    f32x4 Cacc[4];
#pragma unroll
    for (int i = 0; i < 4; ++i) Cacc[i] = (f32x4){0.f, 0.f, 0.f, 0.f};
    float nreg = 0.f, mcar = 0.f;
    unsigned char* const wsp = KWS;
    const bf16_t* proj = (const bf16_t*)(wsp + WS_PROJ); const bf16_t* xt = (const bf16_t*)(wsp + WS_XT);
    const bf16_t* Qg = proj + h * 128; const bf16_t* Kg = proj + 512 + h * 128;
    const bf16_t* KTg = xt + (size_t)(h * 128) * T_; const bf16_t* VTg = xt + (size_t)(512 + h * 256 + vs * 64) * T_;
    bf16_t* HX = (bf16_t*)KOUT + (dir ? (size_t)T_ * 1024 : 0) + h * 256 + vs * 64;
    const float* Ug = (const float*)(wsp + WS_U) + (size_t)stream * S_; const float* PMg = (const float*)(wsp + WS_PM) + (size_t)stream * S_; const float* BCg = (const float*)(wsp + WS_BC) + (size_t)stream * S_;
    const int plast = dir ? 0 : 127;
    for (int c = 0; c < 64; ++c) {
        const int pc = dir ? 63 - c : c; const int p0 = pc * 128; const size_t tok0 = (size_t)b * S_ + p0;
        const float pm_end = PMg[p0 + plast], bL = BCg[p0 + plast];
        const float Mend = fmaxf(mcar, pm_end);
        bf16x8 kreg[4], ktreg[4], vtreg[2], Bq[4]; f32x4 uu[2][2];
#pragma unroll
        for (int i = 0; i < 4; ++i) { const int id = tid + 512 * i, r = id >> 4, sg = id & 15;
            kreg[i] = *(const bf16x8*)(Kg + (tok0 + r) * PLD + sg * 8); ktreg[i] = *(const bf16x8*)(KTg + (size_t)r * T_ + tok0 + sg * 8); }
#pragma unroll
        for (int i = 0; i < 2; ++i) { const int id = tid + 512 * i, r = id >> 4, sg = id & 15;
            vtreg[i] = *(const bf16x8*)(VTg + (size_t)r * T_ + tok0 + sg * 8); uu[i][0] = *(const f32x4*)(Ug + p0 + sg * 8); uu[i][1] = *(const f32x4*)(Ug + p0 + sg * 8 + 4); }
#pragma unroll
        for (int k = 0; k < 4; ++k) Bq[k] = *(const bf16x8*)(Qg + (tok0 + 16 * w + fr) * PLD + 32 * k + 8 * fq);
        float myu = 0.f, mypm = 0.f, mybc = 0.f;
        if (tid < 128) { myu = Ug[p0 + tid]; mypm = PMg[p0 + tid]; mybc = BCg[p0 + tid]; }
#pragma unroll
        for (int i = 0; i < 4; ++i) { const int id = tid + 512 * i, r = id >> 4, sg = id & 15; *(LAS bf16x8*)(Ks + r * LD + sg * 8) = kreg[i]; *(LAS bf16x8*)(KTs + r * LD + sg * 8) = ktreg[i]; }
#pragma unroll
        for (int i = 0; i < 2; ++i) { const int id = tid + 512 * i, r = id >> 4, sg = id & 15; *(LAS bf16x8*)(VTs + r * LD + sg * 8) = vtreg[i];
            float f[8];
#pragma unroll
            for (int j = 0; j < 8; ++j) f[j] = bf2f((unsigned short)vtreg[i][j]) * __expf(uu[i][j >> 2][j & 3] - Mend);
            *(LAS bf16x8*)(VTw + r * LD + sg * 8) = pack8(f[0], f[1], f[2], f[3], f[4], f[5], f[6], f[7]); }
        if (tid < 128) { su[tid] = myu; spm[tid] = mypm; sbc[tid] = mybc; swk[tid] = __expf(myu - Mend); }
        __syncthreads();
        const int tph = 16 * w + fr;
        int tphv = tph - 4 * fq; asm volatile("" : "+v"(tphv));
        const float Mt = fmaxf(mcar, spm[tph]);
        bf16x8 Pf[4]; float rowsum = 0.f;
#pragma unroll
        for (int kk = 0; kk < 4; ++kk) {
            float pv[8];
#pragma unroll
            for (int hh = 0; hh < 2; ++hh) { const int m = 2 * kk + hh;
                f32x4 a = {0.f, 0.f, 0.f, 0.f};
#pragma unroll
                for (int k = 0; k < 4; ++k) { const bf16x8 A = *(const LAS bf16x8*)(Ks + (16 * m + fr) * LD + 32 * k + 8 * fq); a = MFMA16(A, Bq[k], a); }
                const f32x4 us = *(const LAS f32x4*)(su + 16 * m + 4 * fq);
#pragma unroll
                for (int j = 0; j < 4; ++j) { const int sph = 16 * m + j; const bool ok = dir ? (sph >= tphv) : (sph <= tphv);
                    const float wt = ok ? __expf(us[j] - Mt) : 0.f; const float p = a[j] * wt; pv[4 * hh + j] = p; rowsum += p; }
            }
            Pf[kk] = pack8(pv[0], pv[1], pv[2], pv[3], pv[4], pv[5], pv[6], pv[7]);
        }
        rowsum += __shfl_xor(rowsum, 16); rowsum += __shfl_xor(rowsum, 32);
        f32x4 acc[4];
#pragma unroll
        for (int mv = 0; mv < 4; ++mv) { acc[mv] = (f32x4){0.f, 0.f, 0.f, 0.f};
#pragma unroll
            for (int k = 0; k < 4; ++k) { const bf16x8 A = *(const LAS bf16x8*)(Cs + (16 * mv + fr) * LD + 32 * k + 8 * fq); acc[mv] = MFMA16(A, Bq[k], acc[mv]); } }
        float qn = 0.f;
#pragma unroll
        for (int k = 0; k < 4; ++k) { const f32x4 n0 = *(const LAS f32x4*)(snl + 32 * k + 8 * fq), n1 = *(const LAS f32x4*)(snl + 32 * k + 8 * fq + 4);
#pragma unroll
            for (int j = 0; j < 4; ++j) { qn += bf2f((unsigned short)Bq[k][j]) * n0[j]; qn += bf2f((unsigned short)Bq[k][4 + j]) * n1[j]; } }
        qn += __shfl_xor(qn, 16); qn += __shfl_xor(qn, 32);
        const float at = __expf(mcar - Mt);
        const float den = at * qn + rowsum;
#pragma unroll
        for (int mv = 0; mv < 4; ++mv) acc[mv] *= at;
#pragma unroll
        for (int kk = 0; kk < 4; ++kk)
#pragma unroll
            for (int mv = 0; mv < 4; ++mv) { const LAS bf16_t* vp = VTs + (16 * mv + fr) * LD + 32 * kk + 4 * fq;
                const u32x2 lo = *(const LAS u32x2*)vp, hi = *(const LAS u32x2*)(vp + 16);
                u32x4 av; av.x = lo.x; av.y = lo.y; av.z = hi.x; av.w = hi.y;
                acc[mv] = MFMA16(__builtin_bit_cast(bf16x8, av), Pf[kk], acc[mv]); }
        {
            const float dn = fmaxf(fabsf(den), __expf(-(sbc[tph] + Mt))); const float inv = 1.0f / dn;
            bf16_t* op = HX + (tok0 + tph) * 1024 + 4 * fq;
#pragma unroll
            for (int mv = 0; mv < 4; ++mv) { u32x2 o; o.x = pk2(acc[mv][0] * inv, acc[mv][1] * inv); o.y = pk2(acc[mv][2] * inv, acc[mv][3] * inv); *(u32x2*)(op + 16 * mv) = o; }
        }
        const float decay = __expf(mcar - Mend);
#pragma unroll
        for (int mv = 0; mv < 4; ++mv) Cacc[mv] *= decay;
#pragma unroll
        for (int kk = 0; kk < 4; ++kk) { const bf16x8 Bk = *(const LAS bf16x8*)(KTs + (16 * w + fr) * LD + 32 * kk + 8 * fq);
#pragma unroll
            for (int mv = 0; mv < 4; ++mv) { const bf16x8 A = *(const LAS bf16x8*)(VTw + (16 * mv + fr) * LD + 32 * kk + 8 * fq); Cacc[mv] = MFMA16(A, Bk, Cacc[mv]); } }
        if (tid < 128) { float s = 0.f;
#pragma unroll 4
            for (int sg = 0; sg < 16; ++sg) { const bf16x8 kv = *(const LAS bf16x8*)(KTs + tid * LD + sg * 8); const f32x4 w0 = *(const LAS f32x4*)(swk + sg * 8), w1 = *(const LAS f32x4*)(swk + sg * 8 + 4);
#pragma unroll
                for (int j = 0; j < 4; ++j) { s += bf2f((unsigned short)kv[j]) * w0[j]; s += bf2f((unsigned short)kv[4 + j]) * w1[j]; } }
            nreg = decay * nreg + s; }
        __syncthreads();
#pragma unroll
        for (int mv = 0; mv < 4; ++mv)
#pragma unroll
            for (int j = 0; j < 4; ++j) Cs[(16 * mv + 4 * fq + j) * LD + 16 * w + fr] = f2bf(Cacc[mv][j]);
        if (tid < 128) snl[tid] = nreg;
        mcar = bL + Mend;
    }
}

DI void attn_item(int item, LAS unsigned char* lds, int tid) {
    const int lane = tid & 63, w = tid >> 6, q = lane & 31, hf = lane >> 5;
    const int qt = item & 31, hv = (item >> 5) & 15, b = item >> 9, h = hv >> 1, c = hv & 1;
    constexpr int LDK = 72, BUFE = 64 * LDK + 128 * LDK;
    LAS bf16_t* L = (LAS bf16_t*)lds;
    unsigned char* const wsp = KWS;
    const bf16_t* proj = (const bf16_t*)(wsp + WS_PROJ); const bf16_t* xt = (const bf16_t*)(wsp + WS_XT);
    const size_t tokq = (size_t)b * S_ + qt * 256 + 32 * w + q;
    const bf16_t* Qp = proj + tokq * PLD + 2048 + h * 128 + c * 64;
    bf16x8 Bq[4];
#pragma unroll
    for (int ks = 0; ks < 4; ++ks) Bq[ks] = *(const bf16x8*)(Qp + 16 * ks + 8 * hf);
    const bf16_t* Kp = proj + (size_t)b * S_ * PLD + 3072 + h * 128 + c * 64 + (size_t)(tid >> 3) * PLD + (tid & 7) * 8;
    const bf16_t* Vp0 = xt + (size_t)(1536 + h * 128 + (tid >> 3)) * T_ + (size_t)b * S_ + (tid & 7) * 8;
    const bf16_t* Vp1 = Vp0 + (size_t)64 * T_;
    const int kso = (tid >> 3) * LDK + (tid & 7) * 8, vso0 = 64 * LDK + kso, vso1 = vso0 + 64 * LDK;
    f32x16 O[4];
#pragma unroll
    for (int i = 0; i < 4; ++i)
#pragma unroll
        for (int r = 0; r < 16; ++r) O[i][r] = 0.f;
    float l = 0.f, mu = -1e30f;
    bf16x8 rk = *(const bf16x8*)Kp, rv0 = *(const bf16x8*)Vp0, rv1 = *(const bf16x8*)Vp1;
    *(LAS bf16x8*)(L + kso) = rk; *(LAS bf16x8*)(L + vso0) = rv0; *(LAS bf16x8*)(L + vso1) = rv1;
    __syncthreads();
    for (int t = 0; t < 128; ++t) {
        if (t + 1 < 128) { rk = *(const bf16x8*)(Kp + (size_t)(t + 1) * 64 * PLD); rv0 = *(const bf16x8*)(Vp0 + (t + 1) * 64); rv1 = *(const bf16x8*)(Vp1 + (t + 1) * 64); }
        const LAS bf16_t* Ks = L + (t & 1) * BUFE; const LAS bf16_t* VTs = Ks + 64 * LDK;
        f32x16 st[2];
#pragma unroll
        for (int mt = 0; mt < 2; ++mt) {
#pragma unroll
            for (int r = 0; r < 16; ++r) st[mt][r] = 0.f;
#pragma unroll
            for (int ks = 0; ks < 4; ++ks) { const bf16x8 A = *(const LAS bf16x8*)(Ks + (32 * mt + q) * LDK + 16 * ks + 8 * hf); st[mt] = MFMA32(A, Bq[ks], st[mt]); }
        }
        float tmax = st[0][0];
#pragma unroll
        for (int r = 1; r < 16; ++r) tmax = fmaxf(tmax, st[0][r]);
#pragma unroll
        for (int r = 0; r < 16; ++r) tmax = fmaxf(tmax, st[1][r]);
        tmax = fmaxf(tmax, __shfl_xor(tmax, 32));
        if (__any(tmax > mu + 8.0f)) {
            const float mn = fmaxf(mu, tmax), al = __builtin_amdgcn_exp2f(mu - mn);
            l *= al;
#pragma unroll
            for (int i = 0; i < 4; ++i) O[i] *= al;
            mu = mn;
        }
#pragma unroll
        for (int mt = 0; mt < 2; ++mt)
#pragma unroll
            for (int r = 0; r < 16; ++r) { const float p = __builtin_amdgcn_exp2f(st[mt][r] - mu); l += p; st[mt][r] = p; }
#pragma unroll
        for (int mt = 0; mt < 2; ++mt)
#pragma unroll
            for (int j = 0; j < 2; ++j) {
                const bf16x8 Pf = pack8(st[mt][8 * j], st[mt][8 * j + 1], st[mt][8 * j + 2], st[mt][8 * j + 3], st[mt][8 * j + 4], st[mt][8 * j + 5], st[mt][8 * j + 6], st[mt][8 * j + 7]);
#pragma unroll
                for (int mv = 0; mv < 4; ++mv) { const LAS bf16_t* vp = VTs + (32 * mv + q) * LDK + 32 * mt + 16 * j + 4 * hf;
                    const u32x2 lo = *(const LAS u32x2*)vp, hi = *(const LAS u32x2*)(vp + 8);
                    u32x4 av; av.x = lo.x; av.y = lo.y; av.z = hi.x; av.w = hi.y;
                    O[mv] = MFMA32(__builtin_bit_cast(bf16x8, av), Pf, O[mv]); }
            }
        if (t + 1 < 128) { LAS bf16_t* Ln = L + ((t + 1) & 1) * BUFE; *(LAS bf16x8*)(Ln + kso) = rk; *(LAS bf16x8*)(Ln + vso0) = rv0; *(LAS bf16x8*)(Ln + vso1) = rv1; }
        __syncthreads();
    }
    l += __shfl_xor(l, 32);
    const float inv = 1.0f / l;
    bf16_t* op = (bf16_t*)(wsp + WS_RA) + tokq * 2048 + hv * 128 + 4 * hf;
#pragma unroll
    for (int mv = 0; mv < 4; ++mv)
#pragma unroll
        for (int g = 0; g < 4; ++g) { u32x2 o; o.x = pk2(O[mv][4 * g] * inv, O[mv][4 * g + 1] * inv); o.y = pk2(O[mv][4 * g + 2] * inv, O[mv][4 * g + 3] * inv); *(u32x2*)(op + 32 * mv + 8 * g) = o; }
}

DI void p3_headnorm(int tid) {
    const int lane = tid & 63, w = tid >> 6; const int nw = gridDim.x * 8;
    unsigned char* const wsp = KWS;
    const bf16_t* HF = (const bf16_t*)KOUT; const bf16_t* HB = HF + (size_t)T_ * 1024; const bf16_t* OA = (const bf16_t*)(wsp + WS_RA);
    const bf16_t* proj = (const bf16_t*)(wsp + WS_PROJ);
    bf16_t* HMG = (bf16_t*)(wsp + WS_XT); bf16_t* HAN = HMG + (size_t)T_ * 1024;
    const float lam = *(const float*)(wsp + WS_MISC + 64);
    const float* mw = KIN(6); const float* aw = KIN(11);
    for (int t = blockIdx.x * 8 + w; t < T_; t += nw) {
        {
            const int col = (lane >> 4) * 256 + (lane & 15) * 16;
            const u32x4 f0 = *(const u32x4*)(HF + (size_t)t * 1024 + col), f1 = *(const u32x4*)(HF + (size_t)t * 1024 + col + 8);
            const u32x4 b0 = *(const u32x4*)(HB + (size_t)t * 1024 + col), b1 = *(const u32x4*)(HB + (size_t)t * 1024 + col + 8);
            const u32x4 g0 = *(const u32x4*)(proj + (size_t)t * PLD + 1024 + col), g1 = *(const u32x4*)(proj + (size_t)t * PLD + 1024 + col + 8);
            float v[16];
            v[0] = bflo(f0.x) + bflo(b0.x); v[1] = bfhi(f0.x) + bfhi(b0.x); v[2] = bflo(f0.y) + bflo(b0.y); v[3] = bfhi(f0.y) + bfhi(b0.y);
            v[4] = bflo(f0.z) + bflo(b0.z); v[5] = bfhi(f0.z) + bfhi(b0.z); v[6] = bflo(f0.w) + bflo(b0.w); v[7] = bfhi(f0.w) + bfhi(b0.w);
            v[8] = bflo(f1.x) + bflo(b1.x); v[9] = bfhi(f1.x) + bfhi(b1.x); v[10] = bflo(f1.y) + bflo(b1.y); v[11] = bfhi(f1.y) + bfhi(b1.y);
            v[12] = bflo(f1.z) + bflo(b1.z); v[13] = bfhi(f1.z) + bfhi(b1.z); v[14] = bflo(f1.w) + bflo(b1.w); v[15] = bfhi(f1.w) + bfhi(b1.w);
            float s = 0.f;
#pragma unroll
            for (int i = 0; i < 16; ++i) s += v[i] * v[i];
            s += __shfl_xor(s, 1); s += __shfl_xor(s, 2); s += __shfl_xor(s, 4); s += __shfl_xor(s, 8);
            const float r = rsqrtf(s * (1.0f / 256.0f) + EPS_);
            const float gt[16] = {bflo(g0.x), bfhi(g0.x), bflo(g0.y), bfhi(g0.y), bflo(g0.z), bfhi(g0.z), bflo(g0.w), bfhi(g0.w), bflo(g1.x), bfhi(g1.x), bflo(g1.y), bfhi(g1.y), bflo(g1.z), bfhi(g1.z), bflo(g1.w), bfhi(g1.w)};
            float o[16];
#pragma unroll
            for (int i = 0; i < 16; ++i) o[i] = v[i] * r * mw[col + i] * gt[i];
            u32x4 o0, o1; o0.x = pk2(o[0], o[1]); o0.y = pk2(o[2], o[3]); o0.z = pk2(o[4], o[5]); o0.w = pk2(o[6], o[7]); o1.x = pk2(o[8], o[9]); o1.y = pk2(o[10], o[11]); o1.z = pk2(o[12], o[13]); o1.w = pk2(o[14], o[15]);
            *(u32x4*)(HMG + (size_t)t * 1024 + col) = o0; *(u32x4*)(HMG + (size_t)t * 1024 + col + 8) = o1;
        }
        {
            const int hd = lane >> 3, vo = (lane & 7) * 16;
            const bf16_t* p0 = OA + (size_t)t * 2048 + (2 * hd) * 128 + vo; const bf16_t* p1 = p0 + 128;
            const u32x4 a0 = *(const u32x4*)p0, a1 = *(const u32x4*)(p0 + 8), c0 = *(const u32x4*)p1, c1 = *(const u32x4*)(p1 + 8);
            float v[16];
            v[0] = bflo(a0.x) - lam * bflo(c0.x); v[1] = bfhi(a0.x) - lam * bfhi(c0.x); v[2] = bflo(a0.y) - lam * bflo(c0.y); v[3] = bfhi(a0.y) - lam * bfhi(c0.y);
            v[4] = bflo(a0.z) - lam * bflo(c0.z); v[5] = bfhi(a0.z) - lam * bfhi(c0.z); v[6] = bflo(a0.w) - lam * bflo(c0.w); v[7] = bfhi(a0.w) - lam * bfhi(c0.w);
            v[8] = bflo(a1.x) - lam * bflo(c1.x); v[9] = bfhi(a1.x) - lam * bfhi(c1.x); v[10] = bflo(a1.y) - lam * bflo(c1.y); v[11] = bfhi(a1.y) - lam * bfhi(c1.y);
            v[12] = bflo(a1.z) - lam * bflo(c1.z); v[13] = bfhi(a1.z) - lam * bfhi(c1.z); v[14] = bflo(a1.w) - lam * bflo(c1.w); v[15] = bfhi(a1.w) - lam * bfhi(c1.w);
            float s = 0.f;
#pragma unroll
            for (int i = 0; i < 16; ++i) s += v[i] * v[i];
            s += __shfl_xor(s, 1); s += __shfl_xor(s, 2); s += __shfl_xor(s, 4);
            const float r = rsqrtf(s * (1.0f / 128.0f) + EPS_) * 0.8f;
            float o[16];
#pragma unroll
            for (int i = 0; i < 16; ++i) o[i] = v[i] * r * aw[vo + i];
            u32x4 o0, o1; o0.x = pk2(o[0], o[1]); o0.y = pk2(o[2], o[3]); o0.z = pk2(o[4], o[5]); o0.w = pk2(o[6], o[7]); o1.x = pk2(o[8], o[9]); o1.y = pk2(o[10], o[11]); o1.z = pk2(o[12], o[13]); o1.w = pk2(o[14], o[15]);
            *(u32x4*)(HAN + (size_t)t * 1024 + hd * 128 + vo) = o0; *(u32x4*)(HAN + (size_t)t * 1024 + hd * 128 + vo + 8) = o1;
        }
    }
}

__global__ void __launch_bounds__(512) fwd_mega(Params Punused) {
    extern __shared__ __attribute__((aligned(16))) unsigned char lds_raw[];
    LAS unsigned char* lds = (LAS unsigned char*)lds_raw;
    cg::grid_group grid = cg::this_grid();
    const int G = gridDim.x, bx = blockIdx.x;
    unsigned char* ws = KWS;
    unsigned* counter = (unsigned*)(ws + WS_MISC);
    bf16_t* const H = (bf16_t*)(ws + WS_RA);
    bf16_t* const PROJ = (bf16_t*)(ws + WS_PROJ);
    bf16_t* const XT = (bf16_t*)(ws + WS_XT);

    if (!SKIP_P0) {
        const int tid = fresh_tid();
        int total = 0;
        for (int i = 0; i < NREG; ++i) total += c_regs[i].ngroups * (c_regs[i].K >> 6);
        for (int u = bx; u < total; u += G) conv_unit(u, (LAS float*)lds, tid);
        p0_norm_gates((LAS float*)lds, tid);
        float* cosT = (float*)(ws + WS_COS); float* sinT = (float*)(ws + WS_SIN);
        for (int idx = bx * 512 + tid; idx < S_ * 32; idx += G * 512) {
            const int pos = idx >> 5, j = idx & 31; const float ang = (float)pos * c_inv[j];
            const double rev = (double)ang * 0.15915494309189535; const float f = (float)(rev - rint(rev));
            cosT[idx] = __builtin_amdgcn_cosf(f); sinT[idx] = __builtin_amdgcn_sinf(f);
        }
        if (bx == 0 && tid == 0) {
            *counter = 0u;
            float d1 = 0.f, d2 = 0.f;
            const float* l1 = KIN(7); const float* l2 = KIN(8); const float* l3 = KIN(9); const float* l4 = KIN(10);
            for (int i = 0; i < 64; ++i) { d1 += l1[i] * l2[i]; d2 += l3[i] * l4[i]; }
            *(float*)(ws + WS_MISC + 64) = expf(d1) - expf(d2) + 0.2f;
        }
    }
    grid.sync();
    if (!SKIP_P1) {
        gate_prep(fresh_tid());
        { pg8::Gemm g{H, (const bf16_t*)(ws + WS_W1T), T_, 8192, 2048}; pg8::StaticOrder S; S.init(T_, 8192, G, bx);
          EpiMain E{PROJ, KIN(5), (const float*)(ws + WS_COS), (const float*)(ws + WS_SIN)};
          pg8::gemm_phase<EpiMain, pg8::StaticOrder, false>(lds, g, S, E, nullptr); }
        { pg8::Gemm g{(const bf16_t*)(ws + WS_W2T), H, 2560, T_, 2048}; pg8::StaticOrder S; S.init(2560, T_, G, bx);
          EpiPlain E{XT, T_};
          pg8::gemm_phase<EpiPlain, pg8::StaticOrder, false>(lds, g, S, E, nullptr); }
    }
    grid.sync();
    if (!SKIP_P2) {
        const int tid = fresh_tid();
        LAS int* qw = (LAS int*)(lds + LDS_STAGE);
#define GRAB(dst) do { if (tid == 0) *qw = (int)atomicAdd(counter, 1u); __syncthreads(); dst = *qw; __syncthreads(); } while (0)
        int item; GRAB(item);
#ifndef NO_MLSTM
        while (item < N_MLSTM_ITEMS) { mlstm_item(item, lds, tid); GRAB(item); }
#endif
#ifndef NO_ATTN
        while (item < N_MLSTM_ITEMS + N_ATTN_ITEMS) { attn_item(item - N_MLSTM_ITEMS, lds, tid); GRAB(item); }
#endif
#undef GRAB
    }
    grid.sync();
    if (!SKIP_P3) p3_headnorm(fresh_tid());
    grid.sync();
    if (!SKIP_P4) {
        bf16_t* HMG = XT; bf16_t* HAN = XT + (size_t)T_ * 1024; bf16_t* TMP = (bf16_t*)KOUT; bf16_t* MG = H;
        { pg8::Gemm g{HMG, (const bf16_t*)(ws + WS_WBM), T_, 2048, 1024}; pg8::StaticOrder S; S.init(T_, 2048, G, bx);
          EpiBranch<0> E{PROJ, TMP, MG}; pg8::gemm_phase<EpiBranch<0>, pg8::StaticOrder, false>(lds, g, S, E, nullptr); }
        { pg8::Gemm g{HAN, (const bf16_t*)(ws + WS_WBA), T_, 2048, 1024}; pg8::StaticOrder S; S.init(T_, 2048, G, bx);
          EpiBranch<1> E{PROJ, TMP, MG}; pg8::gemm_phase<EpiBranch<1>, pg8::StaticOrder, false>(lds, g, S, E, nullptr); }
    }
    grid.sync();
    if (!SKIP_P5) {
        pg8::Gemm g{H, (const bf16_t*)(ws + WS_WOUT), T_, 2048, 2048}; pg8::StaticOrder S; S.init(T_, 2048, G, bx);
        EpiResid E{KIN(0), KOUT}; pg8::gemm_phase<EpiResid, pg8::StaticOrder, false>(lds, g, S, E, nullptr);
    }
    grid.sync();
    if (!SKIP_P6) rows_rmsnorm<true>(KOUT, KIN(15), H, nullptr, fresh_tid());
    grid.sync();
    if (!SKIP_P7) {
        pg8::Gemm g{H, (const bf16_t*)(ws + WS_WFFI), T_, 2 * DFF_, 2048}; pg8::StaticOrder S; S.init(T_, 2 * DFF_, G, bx);
        EpiSwiglu E{PROJ}; pg8::gemm_phase<EpiSwiglu, pg8::StaticOrder, false>(lds, g, S, E, nullptr);
    }
    grid.sync();
    if (!SKIP_P8) {
        pg8::Gemm g{PROJ, (const bf16_t*)(ws + WS_WFFO), T_, 2048, DFF_}; pg8::StaticOrder S; S.init(T_, 2048, G, bx);
        EpiResid E{KOUT, KOUT}; pg8::gemm_phase<EpiResid, pg8::StaticOrder, false>(lds, g, S, E, nullptr);
    }
    grid.sync();
    if (!SKIP_P9) rows_rmsnorm<false>(KOUT, KIN(18), nullptr, KOUT, fresh_tid());
}

extern "C" void kernel_launch(void* const* d_in, const int* in_sizes, int n_in, void* d_out, int out_size, void* d_ws, size_t ws_size, hipStream_t stream) {
    static int grid_blocks = 0;
    if (!grid_blocks) {
        int dev = 0, cus = 0, per_cu = 0;
        (void)hipGetDevice(&dev);
        (void)hipDeviceGetAttribute(&cus, hipDeviceAttributeMultiprocessorCount, dev);
        (void)hipFuncSetAttribute((const void*)fwd_mega, hipFuncAttributeMaxDynamicSharedMemorySize, LDS_BYTES);
        (void)hipOccupancyMaxActiveBlocksPerMultiprocessor(&per_cu, (const void*)fwd_mega, 512, LDS_BYTES);
        if (per_cu < 1) per_cu = 1;
        grid_blocks = cus * per_cu;
        if (n_in != 19 || ws_size < 940 * MIB) fprintf(stderr, "kernel_launch: unexpected n_in %d / ws_size %zu\n", n_in, ws_size);
    }
    Params p{};
    for (int i = 0; i < 19; ++i) p.in[i] = (const float*)d_in[i];
    p.out = (float*)d_out; p.ws = (unsigned char*)d_ws;
    void* args[] = {&p};
    hipError_t e = hipLaunchCooperativeKernel((const void*)fwd_mega, dim3(grid_blocks), dim3(512), args, LDS_BYTES, stream);
    if (e != hipSuccess) fprintf(stderr, "cooperative launch failed: %s (grid %d)\n", hipGetErrorString(e), grid_blocks);
}
```

```cpp
#include <hip/hip_runtime.h>
#include <hip/hip_cooperative_groups.h>
#include <cstdio>
namespace cg = cooperative_groups;
namespace pg8 {
#define PG8_LAS __attribute__((address_space(3)))
typedef unsigned short bf16_t;
typedef short bf16x8 __attribute__((ext_vector_type(8)));
typedef float f32x4 __attribute__((ext_vector_type(4)));
typedef unsigned u32x4 __attribute__((ext_vector_type(4)));
constexpr int BM = 256, BK = 64, HALF = 128, HTB = HALF * BK * 2  , STAGE_BYTES = 8 * HTB, NXCD = 8, WGM = 8;

__host__ __device__ __forceinline__ int lds_byte(int r, int c) { const int st = (r >> 4) * 2 + (c >> 5), rr = r & 15, cc = c & 31, ob = rr * 64 + cc * 2; return st * 1024 + (ob ^ (((ob >> 9) & 1) << 5)); }
__host__ __device__ __forceinline__ void stage_rc(int b, int& R, int& C) { const int st = b / 1024, sb = b % 1024, swz = sb ^ (((sb >> 9) & 1) << 5); R = (st >> 1) * 16 + swz / 64; C = (st & 1) * 32 + (swz % 64) / 2; }
__host__ __device__ __forceinline__ int perm32(int rho) { const int n = rho >> 4, i = rho & 15; return 8 * (i >> 2) + 4 * n + (i & 3); }

struct Unit { int pm, pn; };
struct Gemm { const bf16_t* A; const bf16_t* Bt; int M, N, K; };

struct StaticOrder {
    int nM, nN, nwg, G, c;
    __host__ __device__ void init(int M, int N, int G_, int c_) { nM = M / BM; nN = N / BM; nwg = nM * nN; G = G_; c = c_; }
    __host__ __device__ bool next(int i, Unit& u) const {
        const long L = (long)i * G + c; if (L >= nwg) return false;
        int wgid = (int)L; { const int q = nwg / NXCD, r = nwg % NXCD, xcd = wgid % NXCD, off = wgid / NXCD; wgid = (xcd < r ? xcd * (q + 1) : r * (q + 1) + (xcd - r) * q) + off; }
        const int nig = WGM * nN, gid = wgid / nig, fm = gid * WGM, gsz = (nM - fm) < WGM ? (nM - fm) : WGM;
        u.pm = fm + ((wgid % nig) % gsz); u.pn = (wgid % nig) / gsz; return true;
    }
    __device__ __forceinline__ void a_ready(const Unit&) const {}
    __device__ __forceinline__ void done(const Unit&) const {}
};
__device__ __forceinline__ unsigned cvt_pk_bf16(float lo, float hi) { unsigned r; asm volatile("v_cvt_pk_bf16_f32 %0, %1, %2" : "=v"(r) : "v"(lo), "v"(hi)); return r; }
typedef float f32x2 __attribute__((ext_vector_type(2)));
template <class Epi, class Sched, bool STAMP = false>
__device__ __forceinline__ void gemm_phase(PG8_LAS unsigned char* lds, const Gemm g, const Sched& S, const Epi& E, unsigned long long* stamps) {
    int tid_ = threadIdx.x; asm volatile("" : "+v"(tid_));
    const int tid = tid_, wid = __builtin_amdgcn_readfirstlane(tid >> 6), lane = tid & 63, wr = wid >> 2, wc = wid & 3, fr = lane & 15, fq = lane >> 4;
    const int K = g.K, nt = K / BK;
    int ts_lo = 0, ts_hi = 0, nts = 0; const unsigned long long rt_entry = STAMP ? (unsigned long long)wall_clock64() : 0ull;
#define PG8_STAMP() do { if (STAMP && wid == 0 && nts < 64) { const unsigned long long _c = (unsigned long long)clock64(); \
        ts_lo = (lane == nts) ? (int)(unsigned)_c : ts_lo; ts_hi = (lane == nts) ? (int)(unsigned)(_c >> 32) : ts_hi; ++nts; } } while (0)
    PG8_STAMP();
    unsigned voffA[2], voffB[2];
#pragma unroll
    for (int i = 0; i < 2; ++i) { int R, C; stage_rc(tid * 16 + i * 8192, R, C); const int Rb = Epi::PERM ? ((R & ~31) + perm32(R & 31)) : R;
        voffA[i] = (unsigned)(R * K + C) * 2u; voffB[i] = (unsigned)(Rb * K + C) * 2u; }
    const size_t kstep = (size_t)(BK * 2);
    const size_t hstep = (size_t)HALF * K * 2;
    const size_t tstep = 2 * hstep;
    const unsigned ldsw = (unsigned)wid * 1024u;
    const int aoff = lds_byte(wr * 64 + fr, fq * 8), boff = lds_byte(wc * 32 + fr, fq * 8);
#define PG8_SA(b, h) (((b) * 2 + (h)) * HTB)
#define PG8_SB(b, h) ((4 + (b) * 2 + (h)) * HTB)
#define PG8_STAGE(bufoff, gbase, voff) do { _Pragma("unroll") for (int _i = 0; _i < 2; ++_i) \
        __builtin_amdgcn_global_load_lds((const unsigned*)((const char*)(gbase) + (voff)[_i]), (PG8_LAS unsigned*)(lds + (bufoff) + ldsw + _i * 8192), 16, 0, 0); } while (0)
#define PG8_LDA(dst, b, h) do { _Pragma("unroll") for (int m = 0; m < 4; ++m) _Pragma("unroll") for (int k = 0; k < 2; ++k) dst[m][k] = *(const PG8_LAS bf16x8*)(lds + PG8_SA(b, h) + aoff + m * 2048 + k * 1024); } while (0)
#define PG8_LDB(dst, b, h) do { _Pragma("unroll") for (int n = 0; n < 2; ++n) _Pragma("unroll") for (int k = 0; k < 2; ++k) dst[n][k] = *(const PG8_LAS bf16x8*)(lds + PG8_SB(b, h) + boff + n * 2048 + k * 1024); } while (0)
#define PG8_MMA(ai, bj, At, Bt) do { __builtin_amdgcn_s_setprio(1); _Pragma("unroll") for (int m = 0; m < 4; ++m) _Pragma("unroll") for (int n = 0; n < 2; ++n) _Pragma("unroll") for (int k = 0; k < 2; ++k) \
        acc[ai][bj][m][n] = __builtin_amdgcn_mfma_f32_16x16x32_bf16(Bt[n][k], At[m][k], acc[ai][bj][m][n], 0, 0, 0); __builtin_amdgcn_s_setprio(0); } while (0)
#define PG8_WAIT_V(n) asm volatile("s_waitcnt vmcnt(" #n ")" ::: "memory")
#define PG8_WAIT_L(n) asm volatile("s_waitcnt lgkmcnt(" #n ")" ::: "memory")
#define PG8_BAR __builtin_amdgcn_s_barrier()
#define PG8_SCHED __builtin_amdgcn_sched_barrier(0)
    Unit cur, nxt; int ui = 0;
    if (!S.next(0, cur)) return;
    f32x4 acc[2][2][4][2];
#pragma unroll
    for (int a = 0; a < 2; ++a)
#pragma unroll
        for (int b = 0; b < 2; ++b)
#pragma unroll
            for (int m = 0; m < 4; ++m)
#pragma unroll
                for (int n = 0; n < 2; ++n) acc[a][b][m][n] = (f32x4){0.f, 0.f, 0.f, 0.f};
    bf16x8 At[4][2], B0[2][2], B1[2][2];
    const char* cA = (const char*)g.A + (size_t)cur.pm * tstep; const char* cB = (const char*)g.Bt + (size_t)cur.pn * tstep;
    S.a_ready(cur);
    PG8_STAGE(PG8_SB(0, 0), cB, voffB); PG8_STAGE(PG8_SA(0, 0), cA, voffA); PG8_STAGE(PG8_SB(0, 1), cB + hstep, voffB); PG8_STAGE(PG8_SA(0, 1), cA + hstep, voffA);
    if (wr == 1) PG8_BAR;
    PG8_WAIT_V(4); PG8_BAR;
    PG8_STAGE(PG8_SB(1, 0), cB + kstep, voffB); PG8_STAGE(PG8_SA(1, 0), cA + kstep, voffA); PG8_STAGE(PG8_SB(1, 1), cB + hstep + kstep, voffB);
    PG8_WAIT_V(6); PG8_BAR;
    PG8_STAMP();
    for (;;) {
        const bool has_next = S.next(ui + 1, nxt);
        const char* nA = has_next ? (const char*)g.A + (size_t)nxt.pm * tstep : cA; const char* nB = has_next ? (const char*)g.Bt + (size_t)nxt.pn * tstep : cB;
        for (int t = 0; t < nt; t += 2) {
            const bool last = (t == nt - 2);
            const char* a1 = cA + (size_t)(t + 1) * kstep;
            const char* a2 = last ? nA : cA + (size_t)(t + 2) * kstep; const char* b2 = last ? nB : cB + (size_t)(t + 2) * kstep;
            const char* a3 = a2 + kstep; const char* b3 = b2 + kstep;
            if (last && has_next) S.a_ready(nxt);
            PG8_LDB(B0, 0, 0); PG8_SCHED; PG8_LDA(At, 0, 0); PG8_STAGE(PG8_SA(1, 1), a1 + hstep, voffA);
            PG8_WAIT_L(8); PG8_BAR; PG8_WAIT_L(0); PG8_MMA(0, 0, At, B0); PG8_BAR; PG8_SCHED;
            PG8_LDB(B1, 0, 1); PG8_STAGE(PG8_SB(0, 0), b2, voffB);
            PG8_BAR; PG8_WAIT_L(0); PG8_MMA(0, 1, At, B1); PG8_BAR;
            PG8_LDA(At, 0, 1); PG8_STAGE(PG8_SA(0, 0), a2, voffA);
            PG8_BAR; PG8_WAIT_L(0); PG8_MMA(1, 0, At, B0); PG8_BAR; PG8_SCHED;
            PG8_STAGE(PG8_SB(0, 1), b2 + hstep, voffB);
            PG8_WAIT_V(6); PG8_BAR; PG8_MMA(1, 1, At, B1); PG8_BAR;
            PG8_LDB(B0, 1, 0); PG8_SCHED; PG8_LDA(At, 1, 0); PG8_STAGE(PG8_SA(0, 1), a2 + hstep, voffA);
            PG8_WAIT_L(8); PG8_BAR; PG8_WAIT_L(0); PG8_MMA(0, 0, At, B0); PG8_BAR; PG8_SCHED;
            PG8_LDB(B1, 1, 1); PG8_STAGE(PG8_SB(1, 0), b3, voffB);
            PG8_BAR; PG8_WAIT_L(0); PG8_MMA(0, 1, At, B1); PG8_BAR;
            PG8_LDA(At, 1, 1); PG8_STAGE(PG8_SA(1, 0), a3, voffA);
            PG8_BAR; PG8_WAIT_L(0); PG8_MMA(1, 0, At, B0); PG8_BAR; PG8_SCHED;
            PG8_STAGE(PG8_SB(1, 1), b3 + hstep, voffB);
            PG8_WAIT_V(6); PG8_BAR; PG8_MMA(1, 1, At, B1); PG8_BAR;
        }
        PG8_STAMP();
        bool keep_acc = false;
        if constexpr (Epi::CHAIN) { keep_acc = E.chain(acc, cur, wr, wc, fr, fq); } else if constexpr (!Epi::AFTER_DRAIN) { E(acc, cur, wr, wc, fr, fq); S.done(cur); }
        PG8_STAMP();
        if (!has_next) break;
        if (!keep_acc)
#pragma unroll
        for (int a = 0; a < 2; ++a)
#pragma unroll
            for (int b = 0; b < 2; ++b)
#pragma unroll
                for (int m = 0; m < 4; ++m)
#pragma unroll
                    for (int n = 0; n < 2; ++n) acc[a][b][m][n] = (f32x4){0.f, 0.f, 0.f, 0.f};
        cur = nxt; cA = nA; cB = nB; ++ui;
    }
    PG8_WAIT_V(0);
    if (wr == 0) PG8_BAR;
    PG8_BAR;
    if constexpr (Epi::AFTER_DRAIN) { E.fused(acc, cur, wr, wc, fr, fq, lds, wid, lane); S.done(cur); }
    PG8_STAMP();
    if (STAMP && wid == 0) { stamps[lane] = lane < nts ? (((unsigned long long)(unsigned)ts_hi << 32) | (unsigned)ts_lo) : 0ull;
        if (lane == 62) stamps[62] = rt_entry; if (lane == 63) stamps[63] = (unsigned long long)wall_clock64(); }
#undef PG8_STAMP
#undef PG8_SA
#undef PG8_SB
#undef PG8_STAGE
#undef PG8_LDA
#undef PG8_LDB
#undef PG8_MMA
#undef PG8_WAIT_V
#undef PG8_WAIT_L
#undef PG8_BAR
#undef PG8_SCHED
}
}

using pg8::bf16_t; using pg8::bf16x8; using pg8::f32x4; using pg8::u32x4;
typedef float f32x16 __attribute__((ext_vector_type(16)));
typedef float f32x2v __attribute__((ext_vector_type(2)));
typedef unsigned u32x2 __attribute__((ext_vector_type(2)));
typedef __bf16 bf16v2 __attribute__((ext_vector_type(2)));
#ifndef SKIP_P0
#define SKIP_P0 0
#endif
#ifndef SKIP_P1
#define SKIP_P1 0
#endif
#ifndef SKIP_P2
#define SKIP_P2 0
#endif
#ifndef SKIP_P3
#define SKIP_P3 0
#endif
#ifndef SKIP_P4
#define SKIP_P4 0
#endif
#ifndef SKIP_P5
#define SKIP_P5 0
#endif
#ifndef SKIP_P6
#define SKIP_P6 0
#endif
#ifndef SKIP_P7
#define SKIP_P7 0
#endif
#ifndef SKIP_P8
#define SKIP_P8 0
#endif
#ifndef SKIP_P9
#define SKIP_P9 0
#endif
#ifndef REP_P0
#define REP_P0 1
#endif
#ifndef REP_P1
#define REP_P1 1
#endif
#ifndef REP_P2
#define REP_P2 1
#endif
#ifndef REP_P3
#define REP_P3 1
#endif
#ifndef REP_P4
#define REP_P4 1
#endif
#ifndef REP_P5
#define REP_P5 1
#endif
#ifndef REP_P6
#define REP_P6 1
#endif
#ifndef REP_P7
#define REP_P7 1
#endif
#ifndef REP_P8
#define REP_P8 1
#endif
#ifndef REP_P9
#define REP_P9 1
#endif
#define LAS __attribute__((address_space(3)))
#define DI __device__ __forceinline__

constexpr int T_ = 32768, D_ = 2048, S_ = 8192, DFF_ = 5632, DIN_ = 10256, PLD = 4096;
constexpr size_t MIB = (size_t)1 << 20;
constexpr size_t WS_W1T = 0, WS_W2T = 32 * MIB, WS_WBM = 42 * MIB, WS_WBA = 46 * MIB, WS_WOUT = 50 * MIB, WS_WFFI = 58 * MIB, WS_WFFO = 102 * MIB;
constexpr size_t WS_RA = 128 * MIB, WS_PROJ = 256 * MIB, WS_GT = 512 * MIB, WS_X2 = 608 * MIB, WS_XT = 768 * MIB, WS_SMALL = 928 * MIB;
constexpr size_t WS_G16 = WS_SMALL, WS_BC = WS_SMALL + 2 * MIB, WS_U = WS_SMALL + 3 * MIB, WS_PM = WS_SMALL + 4 * MIB, WS_COS = WS_SMALL + 5 * MIB, WS_SIN = WS_SMALL + 6 * MIB, WS_MISC = WS_SMALL + 7 * MIB, WS_BAR = WS_SMALL + 7 * MIB + 65536;
constexpr int LDS_STAGE = 131072, LDS_BYTES = LDS_STAGE + 1024;
constexpr float EPS_ = 1e-6f;
constexpr float KSCALE = 0.08838834764831845f;
constexpr float QSCALE = 0.125f * 1.4426950408889634f;
constexpr int N_MLSTM_ITEMS = 128, N_ATTN_ITEMS = 2048;

struct Params { const float* in[19]; float* out; unsigned char* ws; };
__device__ __forceinline__ unsigned long long karg64(int off) { unsigned long long r; asm volatile("s_load_dwordx2 %0, %1, %2\n\ts_waitcnt lgkmcnt(0)" : "=s"(r) : "s"(__builtin_amdgcn_kernarg_segment_ptr()), "n"(off)); return r; }
__device__ __forceinline__ unsigned long long karg64d(int off) { unsigned long long r; asm volatile("s_load_dwordx2 %0, %1, %2\n\ts_waitcnt lgkmcnt(0)" : "=s"(r) : "s"(__builtin_amdgcn_kernarg_segment_ptr()), "s"(__builtin_amdgcn_readfirstlane(off))); return r; }
#define GAS __attribute__((address_space(1)))
#define KIN(i) ((const float*)(const GAS float*)karg64(8 * (i)))
#define KOUT ((float*)(GAS float*)karg64(152))
#define KWS ((unsigned char*)(GAS unsigned char*)karg64(160))

__constant__ float c_inv[32] = {1.000000000e+00f, 7.498942614e-01f, 5.623413324e-01f, 4.216965139e-01f, 3.162277639e-01f, 2.371373773e-01f, 1.778279394e-01f, 1.333521307e-01f, 1.000000015e-01f, 7.498941571e-02f, 5.623413250e-02f, 4.216965288e-02f, 3.162277490e-02f, 2.371373773e-02f, 1.778279431e-02f, 1.333521493e-02f, 9.999999776e-03f, 7.498941850e-03f, 5.623413250e-03f, 4.216964822e-03f, 3.162277630e-03f, 2.371373586e-03f, 1.778279431e-03f, 1.333521446e-03f, 1.000000047e-03f, 7.498942432e-04f, 5.623413017e-04f, 4.216965172e-04f, 3.162277571e-04f, 2.371373703e-04f, 1.778279402e-04f, 1.333521504e-04f};

struct ConvReg { int src, ld, K, ngroups, kind, col0; unsigned long long dst; float scale; int pad; };
constexpr int NREG = 13;
__constant__ ConvReg c_regs[NREG] = {
    {2, DIN_, 2048, 8, 0, 0, WS_W1T, 1.0f, 0},
    {2, DIN_, 2048, 8, 0, 512, WS_W1T + 512ull * 4096, KSCALE, 0},
    {2, DIN_, 2048, 16, 0, 2048, WS_W1T + 1024ull * 4096, 1.0f, 0},
    {2, DIN_, 2048, 16, 1, 3088, WS_W1T + 2048ull * 4096, QSCALE, 0},
    {2, DIN_, 2048, 16, 1, 4112, WS_W1T + 3072ull * 4096, 1.0f, 0},
    {2, DIN_, 2048, 64, 0, 6160, WS_W1T + 4096ull * 4096, 1.0f, 0},
    {2, DIN_, 2048, 16, 0, 1024, WS_W2T, 1.0f, 0},
    {2, DIN_, 2048, 16, 0, 5136, WS_W2T + 1024ull * 4096, 1.0f, 0},
    {12, 2048, 1024, 32, 0, 0, WS_WBM, 1.0f, 0},
    {13, 2048, 1024, 32, 0, 0, WS_WBA, 1.0f, 0},
    {14, 2048, 2048, 32, 0, 0, WS_WOUT, 1.0f, 0},
    {16, 2 * DFF_, 2048, 176, 2, 0, WS_WFFI, 1.0f, 0},
    {17, 2048, DFF_, 32, 0, 0, WS_WFFO, 1.0f, 0}};

DI unsigned short f2bf(float f) { unsigned u = __float_as_uint(f); u += 0x7fffu + ((u >> 16) & 1u); return (unsigned short)(u >> 16); }
DI float bf2f(unsigned short b) { return __uint_as_float(((unsigned)b) << 16); }
DI float bflo(unsigned w) { return __uint_as_float(w << 16); }
DI float bfhi(unsigned w) { return __uint_as_float(w & 0xffff0000u); }
DI unsigned pk2(float lo, float hi) { f32x2v v = {lo, hi}; bf16v2 r = __builtin_convertvector(v, bf16v2); return __builtin_bit_cast(unsigned, r); }
DI bf16x8 pack8(float a0, float a1, float a2, float a3, float a4, float a5, float a6, float a7) { u32x4 p; p.x = pk2(a0, a1); p.y = pk2(a2, a3); p.z = pk2(a4, a5); p.w = pk2(a6, a7); return __builtin_bit_cast(bf16x8, p); }
DI float sigmoidf_(float x) { return __builtin_amdgcn_rcpf(1.0f + __expf(-x)); }
DI float wave_sum(float v) { for (int o = 32; o >= 1; o >>= 1) v += __shfl_xor(v, o); return v; }
DI int fresh_tid() { int t = threadIdx.x; asm volatile("" : "+v"(t)); return t; }
#define MFMA16(a, b, c) __builtin_amdgcn_mfma_f32_16x16x32_bf16((a), (b), (c), 0, 0, 0)
#define MFMA32(a, b, c) __builtin_amdgcn_mfma_f32_32x32x16_bf16((a), (b), (c), 0, 0, 0)

struct ConvU { const float* src; bf16_t* dst; int ld, K, kind; float scale; };
DI ConvU conv_decode(int u, int tid) {
    int ri = 0, lu = u;
    for (; ri < NREG - 1; ++ri) { const int n = c_regs[ri].ngroups * (c_regs[ri].K >> 6); if (lu < n) break; lu -= n; }
    ConvU U; U.ld = c_regs[ri].ld; U.K = c_regs[ri].K; U.kind = c_regs[ri].kind; U.scale = c_regs[ri].scale;
    const int nK = U.K >> 6, g = lu / nK, kt = lu - g * nK;
    int cbase;
    if (U.kind == 2) { const int pn = g >> 2, q = g & 3; cbase = (q < 2) ? (128 * pn + 64 * q) : (DFF_ + 128 * pn + 64 * (q - 2)); }
    else cbase = c_regs[ri].col0 + 64 * g;
    U.src = ((const float*)(const GAS float*)karg64d(8 * c_regs[ri].src)) + (size_t)(64 * kt) * U.ld + cbase + (size_t)(tid >> 6) * U.ld + (tid & 63);
    U.dst = (bf16_t*)(KWS + c_regs[ri].dst) + (size_t)(64 * g + (tid >> 3)) * U.K + 64 * kt + (tid & 7) * 8;
    return U;
}
DI void conv_units(int u0, int u1, int stride, LAS float* tile, int tid) {
    if (u0 >= u1) return;
    ConvU U = conv_decode(u0, tid);
    float v[8];
#pragma unroll
    for (int i = 0; i < 8; ++i) v[i] = U.src[(size_t)(8 * i) * U.ld];
    for (int u = u0; u < u1; u += stride) {
        const bool more = u + stride < u1;
        ConvU N = U; float nv[8];
        if (more) { N = conv_decode(u + stride, tid);
#pragma unroll
            for (int i = 0; i < 8; ++i) nv[i] = N.src[(size_t)(8 * i) * N.ld]; }
        { const int col = tid & 63, kr0 = tid >> 6;
#pragma unroll
          for (int i = 0; i < 8; ++i) tile[(kr0 + 8 * i) * 65 + col] = v[i] * U.scale; }
        __syncthreads();
        { const int rr = tid >> 3, ks = (tid & 7) * 8;
          const int sc = (U.kind == 1) ? ((rr & 1) ? (rr >> 1) + 32 : (rr >> 1)) : rr;
          float w[8];
#pragma unroll
          for (int j = 0; j < 8; ++j) w[j] = tile[(ks + j) * 65 + sc];
          *(bf16x8*)U.dst = pack8(w[0], w[1], w[2], w[3], w[4], w[5], w[6], w[7]); }
        __syncthreads();
        if (more) { U = N;
#pragma unroll
            for (int i = 0; i < 8; ++i) v[i] = nv[i]; }
    }
}

DI void p0_norm_gates(LAS float* Wg, int tid) {
    const float* x = KIN(0); const float* n1 = KIN(1); const float* w_in = KIN(2);
    for (int e = tid; e < 16 * 2048; e += 512) { const int k = e >> 4, j = e & 15; Wg[j * 2048 + k] = w_in[(size_t)k * DIN_ + 3072 + j] * n1[k]; }
    __syncthreads();
    const int lane = tid & 63, w = tid >> 6;
    unsigned char* const wsp = KWS; bf16_t* H = (bf16_t*)(wsp + WS_RA); float* G16 = (float*)(wsp + WS_G16);
    const int nw = gridDim.x * 8;
    for (int pr = blockIdx.x * 8 + w; pr < T_ / 2; pr += nw) {
        const float* xa = x + (size_t)(2 * pr) * D_; const float* xb = xa + D_;
        float sa = 0.f, sb = 0.f;
        float ga[16], gb[16];
#pragma unroll
        for (int j = 0; j < 16; ++j) { ga[j] = 0.f; gb[j] = 0.f; }
#pragma unroll 1
        for (int i = 0; i < 8; ++i) {
            const f32x4 va = *(const f32x4*)(xa + 4 * lane + 256 * i), vb = *(const f32x4*)(xb + 4 * lane + 256 * i);
            sa += va[0] * va[0] + va[1] * va[1] + va[2] * va[2] + va[3] * va[3]; sb += vb[0] * vb[0] + vb[1] * vb[1] + vb[2] * vb[2] + vb[3] * vb[3];
#pragma unroll
            for (int j = 0; j < 16; ++j) { const f32x4 wv = *(const LAS f32x4*)(Wg + j * 2048 + 4 * lane + 256 * i);
                ga[j] += va[0] * wv[0] + va[1] * wv[1] + va[2] * wv[2] + va[3] * wv[3];
                gb[j] += vb[0] * wv[0] + vb[1] * wv[1] + vb[2] * wv[2] + vb[3] * wv[3]; }
        }
        sa = wave_sum(sa); sb = wave_sum(sb);
        const float ra = rsqrtf(sa * (1.0f / D_) + EPS_), rb = rsqrtf(sb * (1.0f / D_) + EPS_);
        float oa = 0.f, ob = 0.f;
#pragma unroll
        for (int j = 0; j < 16; ++j) { const float ta = wave_sum(ga[j]), tb = wave_sum(gb[j]); if (lane == j) { oa = ta; ob = tb; } }
        if (lane < 16) { G16[(size_t)(2 * pr) * 16 + lane] = oa * ra; G16[(size_t)(2 * pr + 1) * 16 + lane] = ob * rb; }
#pragma unroll 2
        for (int i = 0; i < 8; ++i) { const f32x4 nw4 = *(const f32x4*)(n1 + 4 * lane + 256 * i);
            const f32x4 va = *(const f32x4*)(xa + 4 * lane + 256 * i), vb = *(const f32x4*)(xb + 4 * lane + 256 * i);
            u32x2 oa2, ob2;
            oa2.x = pk2(va[0] * ra * nw4[0], va[1] * ra * nw4[1]); oa2.y = pk2(va[2] * ra * nw4[2], va[3] * ra * nw4[3]);
            ob2.x = pk2(vb[0] * rb * nw4[0], vb[1] * rb * nw4[1]); ob2.y = pk2(vb[2] * rb * nw4[2], vb[3] * rb * nw4[3]);
            *(u32x2*)(H + (size_t)(2 * pr) * D_ + 4 * lane + 256 * i) = oa2; *(u32x2*)(H + (size_t)(2 * pr + 1) * D_ + 4 * lane + 256 * i) = ob2; }
    }
}

template <bool TO_BF16>
DI void rows_rmsnorm(const float* X, const float* wgt, bf16_t* Ob, float* Of, int tid) {
    const int lane = tid & 63, w = tid >> 6; const int nw = gridDim.x * 8;
    for (int t = blockIdx.x * 8 + w; t < T_; t += nw) {
        const float* xr = X + (size_t)t * D_;
        f32x4 v[8]; float s = 0.f;
#pragma unroll
        for (int i = 0; i < 8; ++i) { v[i] = *(const f32x4*)(xr + 4 * lane + 256 * i); s += v[i][0] * v[i][0] + v[i][1] * v[i][1] + v[i][2] * v[i][2] + v[i][3] * v[i][3]; }
        s = wave_sum(s); const float r = rsqrtf(s * (1.0f / D_) + EPS_);
#pragma unroll
        for (int i = 0; i < 8; ++i) { const f32x4 g = *(const f32x4*)(wgt + 4 * lane + 256 * i);
            if (TO_BF16) { u32x2 o; o.x = pk2(v[i][0] * r * g[0], v[i][1] * r * g[1]); o.y = pk2(v[i][2] * r * g[2], v[i][3] * r * g[3]); *(u32x2*)(Ob + (size_t)t * D_ + 4 * lane + 256 * i) = o; }
            else { f32x4 o; o[0] = v[i][0] * r * g[0]; o[1] = v[i][1] * r * g[1]; o[2] = v[i][2] * r * g[2]; o[3] = v[i][3] * r * g[3]; *(f32x4*)(Of + (size_t)t * D_ + 4 * lane + 256 * i) = o; }
        }
    }
}

template <bool TO_BF16>
DI void rows_rmsnorm_bf(const bf16_t* X, const float* wgt, bf16_t* Ob, float* Of, int tid) {
    const int lane = tid & 63, w = tid >> 6; const int nw = gridDim.x * 8;
    for (int tp = blockIdx.x * 8 + w; tp < T_ / 2; tp += nw) {
        u32x4 v[2][4]; float s[2] = {0.f, 0.f};
#pragma unroll
        for (int h = 0; h < 2; ++h) { const bf16_t* xr = X + (size_t)(2 * tp + h) * D_;
#pragma unroll
            for (int i = 0; i < 4; ++i) v[h][i] = *(const u32x4*)(xr + 8 * lane + 512 * i); }
#pragma unroll
        for (int h = 0; h < 2; ++h)
#pragma unroll
            for (int i = 0; i < 4; ++i) { const u32x4 q = v[h][i];
                s[h] += bflo(q.x) * bflo(q.x) + bfhi(q.x) * bfhi(q.x) + bflo(q.y) * bflo(q.y) + bfhi(q.y) * bfhi(q.y) + bflo(q.z) * bflo(q.z) + bfhi(q.z) * bfhi(q.z) + bflo(q.w) * bflo(q.w) + bfhi(q.w) * bfhi(q.w); }
        s[0] = wave_sum(s[0]); s[1] = wave_sum(s[1]);
#pragma unroll
        for (int i = 0; i < 4; ++i) { const f32x4 g0 = *(const f32x4*)(wgt + 8 * lane + 512 * i), g1 = *(const f32x4*)(wgt + 8 * lane + 512 * i + 4);
#pragma unroll
            for (int h = 0; h < 2; ++h) { const float r = rsqrtf(s[h] * (1.0f / D_) + EPS_); const u32x4 q = v[h][i]; const size_t o_ = (size_t)(2 * tp + h) * D_ + 8 * lane + 512 * i;
                const float o0 = bflo(q.x) * r * g0[0], o1 = bfhi(q.x) * r * g0[1], o2 = bflo(q.y) * r * g0[2], o3 = bfhi(q.y) * r * g0[3];
                const float o4 = bflo(q.z) * r * g1[0], o5 = bfhi(q.z) * r * g1[1], o6 = bflo(q.w) * r * g1[2], o7 = bfhi(q.w) * r * g1[3];
                if (TO_BF16) { u32x4 o; o.x = pk2(o0, o1); o.y = pk2(o2, o3); o.z = pk2(o4, o5); o.w = pk2(o6, o7); *(u32x4*)(Ob + o_) = o; }
                else { *(f32x4*)(Of + o_) = (f32x4){o0, o1, o2, o3}; *(f32x4*)(Of + o_ + 4) = (f32x4){o4, o5, o6, o7}; } } }
    }
}

struct EpiMain {
    static constexpr bool PERM = true, AFTER_DRAIN = false, CHAIN = false;
    bf16_t* O; bf16_t* GT; const float* gbias; const float* cosT; const float* sinT;
    DI void operator()(const f32x4 (&acc)[2][2][4][2], const pg8::Unit& u, int wr, int wc, int fr, int fq) const {
        const int row0 = u.pm * 256 + wr * 64 + fr, colb = u.pn * 256 + wc * 32 + 8 * fq;
        const int ty = (u.pn < 4) ? 0 : (u.pn < 8) ? 1 : (u.pn < 16) ? 2 : 3;
#pragma unroll
        for (int ai = 0; ai < 2; ++ai)
#pragma unroll
            for (int m = 0; m < 4; ++m) {
                const int row = row0 + ai * 128 + m * 16; bf16_t* rowp = O + (size_t)row * PLD + colb;
                f32x4 cs = {1.f, 1.f, 1.f, 1.f}, sn = {0.f, 0.f, 0.f, 0.f};
                if (ty == 2) { const int pos = row & (S_ - 1), j0 = 16 * (wc & 1) + 4 * fq; cs = *(const f32x4*)(cosT + pos * 32 + j0); sn = *(const f32x4*)(sinT + pos * 32 + j0); }
                u32x4 gq = {0u, 0u, 0u, 0u};
#pragma unroll
                for (int bj = 0; bj < 2; ++bj) {
                    f32x4 v0 = acc[ai][bj][m][0], v1 = acc[ai][bj][m][1];
                    if (ty == 1) {
#pragma unroll
                        for (int j = 0; j < 4; ++j) { v0[j] = sigmoidf_(v0[j]); v1[j] = sigmoidf_(v1[j]); }
                    } else if (ty == 2) {
                        f32x4 a, b;
                        a[0] = v0[0] * cs[0] - v0[1] * sn[0]; a[1] = v0[0] * sn[0] + v0[1] * cs[0];
                        a[2] = v0[2] * cs[1] - v0[3] * sn[1]; a[3] = v0[2] * sn[1] + v0[3] * cs[1];
                        b[0] = v1[0] * cs[2] - v1[1] * sn[2]; b[1] = v1[0] * sn[2] + v1[1] * cs[2];
                        b[2] = v1[2] * cs[3] - v1[3] * sn[3]; b[3] = v1[2] * sn[3] + v1[3] * cs[3];
                        v0 = a; v1 = b;
                    } else if (ty == 3) {
                        const float* bp = gbias + (colb + bj * 128 - 4096);
                        const f32x4 b0 = *(const f32x4*)bp, b1 = *(const f32x4*)(bp + 4);
#pragma unroll
                        for (int j = 0; j < 4; ++j) { v0[j] = sigmoidf_(v0[j] + b0[j]); v1[j] = sigmoidf_(v1[j] + b1[j]); }
                        const unsigned w0 = __float2uint_rn(v0[0] * 255.f) | (__float2uint_rn(v0[1] * 255.f) << 8) | (__float2uint_rn(v0[2] * 255.f) << 16) | (__float2uint_rn(v0[3] * 255.f) << 24);
                        const unsigned w1 = __float2uint_rn(v1[0] * 255.f) | (__float2uint_rn(v1[1] * 255.f) << 8) | (__float2uint_rn(v1[2] * 255.f) << 16) | (__float2uint_rn(v1[3] * 255.f) << 24);
                        if (bj == 0) { gq.x = w0; gq.y = w1; } else { gq.z = w0; gq.w = w1; }
                    }
                    if (ty != 3) { u32x4 o; o.x = pk2(v0[0], v0[1]); o.y = pk2(v0[2], v0[3]); o.z = pk2(v1[0], v1[1]); o.w = pk2(v1[2], v1[3]);
                        __builtin_nontemporal_store(o, (u32x4*)(rowp + bj * 128)); }
                }
                if (ty == 3) __builtin_nontemporal_store(gq, (u32x4*)((unsigned char*)GT + ((size_t)(u.pm * 16 + (u.pn - 16)) * 8 + (ai * 4 + m)) * 8192 + (size_t)(((wr * 4 + wc) * 4 + fq) * 16 + fr) * 16));
            }
    }
};
struct EpiPlain {
    static constexpr bool PERM = true, AFTER_DRAIN = false, CHAIN = false;
    bf16_t* O; int ldc;
    DI void operator()(const f32x4 (&acc)[2][2][4][2], const pg8::Unit& u, int wr, int wc, int fr, int fq) const {
        const int row0 = u.pm * 256 + wr * 64 + fr, colb = u.pn * 256 + wc * 32 + 8 * fq;
#pragma unroll
        for (int ai = 0; ai < 2; ++ai)
#pragma unroll
            for (int m = 0; m < 4; ++m) { bf16_t* rowp = O + (size_t)(row0 + ai * 128 + m * 16) * ldc + colb;
#pragma unroll
                for (int bj = 0; bj < 2; ++bj) { const f32x4 v0 = acc[ai][bj][m][0], v1 = acc[ai][bj][m][1];
                    u32x4 o; o.x = pk2(v0[0], v0[1]); o.y = pk2(v0[2], v0[3]); o.z = pk2(v1[0], v1[1]); o.w = pk2(v1[2], v1[3]);
                    __builtin_nontemporal_store(o, (u32x4*)(rowp + bj * 128)); } }
    }
};
struct BranchOrder : pg8::StaticOrder {
    __device__ bool next(int i, pg8::Unit& u) const { if (!pg8::StaticOrder::next(i >> 1, u)) return false; if (i & 1) { u.pm += T_ / 256; u.pn += 2048 / 256; } return true; }
};
struct EpiBranchChain {
    static constexpr bool PERM = true, AFTER_DRAIN = false, CHAIN = true;
    const bf16_t* gt; bf16_t* mg;
    DI bool chain(f32x4 (&acc)[2][2][4][2], const pg8::Unit& u, int wr, int wc, int fr, int fq) const {
        const bool second = u.pm >= T_ / 256;
        const int pm = second ? u.pm - T_ / 256 : u.pm, pn = second ? u.pn - 2048 / 256 : u.pn;
        const int row0 = pm * 256 + wr * 64 + fr, colb = pn * 256 + wc * 32 + 8 * fq;
#pragma unroll
        for (int ai = 0; ai < 2; ++ai)
#pragma unroll
            for (int m = 0; m < 4; ++m) { const int row = row0 + ai * 128 + m * 16;
#pragma unroll
                for (int bj = 0; bj < 2; ++bj) { const int col = colb + bj * 128;
                    const size_t gsl = (size_t)(ai * 4 + m) * 8192 + (size_t)(((wr * 4 + wc) * 4 + fq) * 16 + fr) * 16 + bj * 8;
                    const u32x2 gar = *(const u32x2*)((const unsigned char*)gt + (size_t)(pm * 16 + pn + 8) * 65536 + gsl);
                    const float k255 = 1.0f / 255.0f;
                    const float a0 = fmaxf((float)(gar.x & 255u) * k255, 1e-30f), a1 = fmaxf((float)((gar.x >> 8) & 255u) * k255, 1e-30f), a2 = fmaxf((float)((gar.x >> 16) & 255u) * k255, 1e-30f), a3 = fmaxf((float)(gar.x >> 24) * k255, 1e-30f);
                    const float a4 = fmaxf((float)(gar.y & 255u) * k255, 1e-30f), a5 = fmaxf((float)((gar.y >> 8) & 255u) * k255, 1e-30f), a6 = fmaxf((float)((gar.y >> 16) & 255u) * k255, 1e-30f), a7 = fmaxf((float)(gar.y >> 24) * k255, 1e-30f);
                    f32x4& v0 = acc[ai][bj][m][0]; f32x4& v1 = acc[ai][bj][m][1];
                    if (!second) {
                        const u32x2 gm = *(const u32x2*)((const unsigned char*)gt + (size_t)(pm * 16 + pn) * 65536 + gsl);
                        v0[0] *= (float)(gm.x & 255u) * k255 * __builtin_amdgcn_rcpf(a0); v0[1] *= (float)((gm.x >> 8) & 255u) * k255 * __builtin_amdgcn_rcpf(a1);
                        v0[2] *= (float)((gm.x >> 16) & 255u) * k255 * __builtin_amdgcn_rcpf(a2); v0[3] *= (float)(gm.x >> 24) * k255 * __builtin_amdgcn_rcpf(a3);
                        v1[0] *= (float)(gm.y & 255u) * k255 * __builtin_amdgcn_rcpf(a4); v1[1] *= (float)((gm.y >> 8) & 255u) * k255 * __builtin_amdgcn_rcpf(a5);
                        v1[2] *= (float)((gm.y >> 16) & 255u) * k255 * __builtin_amdgcn_rcpf(a6); v1[3] *= (float)(gm.y >> 24) * k255 * __builtin_amdgcn_rcpf(a7);
                    } else {
                        u32x4 o; o.x = pk2(v0[0] * a0, v0[1] * a1); o.y = pk2(v0[2] * a2, v0[3] * a3);
                        o.z = pk2(v1[0] * a4, v1[1] * a5); o.w = pk2(v1[2] * a6, v1[3] * a7);
                        *(u32x4*)(mg + (size_t)row * D_ + col) = o;
                    } } }
        return !second;
    }
};
struct EpiResid {
    static constexpr bool PERM = false, AFTER_DRAIN = false, CHAIN = false;
    const float* base; float* out;
    DI void operator()(const f32x4 (&acc)[2][2][4][2], const pg8::Unit& u, int wr, int wc, int fr, int fq) const {
        const int row0 = u.pm * 256 + wr * 64 + fr, col0 = u.pn * 256 + wc * 32 + 4 * fq;
#pragma unroll
        for (int ai = 0; ai < 2; ++ai)
#pragma unroll
            for (int m = 0; m < 4; ++m) { const size_t off = (size_t)(row0 + ai * 128 + m * 16) * D_ + col0;
#pragma unroll
                for (int bj = 0; bj < 2; ++bj)
#pragma unroll
                    for (int n = 0; n < 2; ++n) { const f32x4 b = *(const f32x4*)(base + off + bj * 128 + n * 16); *(f32x4*)(out + off + bj * 128 + n * 16) = b + acc[ai][bj][m][n]; } }
    }
};
struct EpiResidBf {
    static constexpr bool PERM = true, AFTER_DRAIN = false, CHAIN = false;
    const float* base; bf16_t* out;
    DI void operator()(const f32x4 (&acc)[2][2][4][2], const pg8::Unit& u, int wr, int wc, int fr, int fq) const {
        const int row0 = u.pm * 256 + wr * 64 + fr, col0 = u.pn * 256 + wc * 32 + 8 * fq;
#pragma unroll
        for (int ai = 0; ai < 2; ++ai)
#pragma unroll
            for (int m = 0; m < 4; ++m) { const size_t off = (size_t)(row0 + ai * 128 + m * 16) * D_ + col0;
#pragma unroll
                for (int bj = 0; bj < 2; ++bj) { const f32x4 b0 = *(const f32x4*)(base + off + bj * 128), b1 = *(const f32x4*)(base + off + bj * 128 + 4);
                    const f32x4 v0 = b0 + acc[ai][bj][m][0], v1 = b1 + acc[ai][bj][m][1];
                    u32x4 o; o.x = pk2(v0[0], v0[1]); o.y = pk2(v0[2], v0[3]); o.z = pk2(v1[0], v1[1]); o.w = pk2(v1[2], v1[3]);
                    *(u32x4*)(out + off + bj * 128) = o; } }
    }
};
struct EpiResidBfBf {
    static constexpr bool PERM = true, AFTER_DRAIN = false, CHAIN = false;
    const bf16_t* base; bf16_t* out;
    DI void operator()(const f32x4 (&acc)[2][2][4][2], const pg8::Unit& u, int wr, int wc, int fr, int fq) const {
        const int row0 = u.pm * 256 + wr * 64 + fr, col0 = u.pn * 256 + wc * 32 + 8 * fq;
#pragma unroll
        for (int ai = 0; ai < 2; ++ai)
#pragma unroll
            for (int m = 0; m < 4; ++m) { const size_t off = (size_t)(row0 + ai * 128 + m * 16) * D_ + col0;
#pragma unroll
                for (int bj = 0; bj < 2; ++bj) { const u32x4 b = *(const u32x4*)(base + off + bj * 128);
                    const f32x4 v0 = acc[ai][bj][m][0], v1 = acc[ai][bj][m][1];
                    u32x4 o; o.x = pk2(v0[0] + bflo(b.x), v0[1] + bfhi(b.x)); o.y = pk2(v0[2] + bflo(b.y), v0[3] + bfhi(b.y)); o.z = pk2(v1[0] + bflo(b.z), v1[1] + bfhi(b.z)); o.w = pk2(v1[2] + bflo(b.w), v1[3] + bfhi(b.w));
                    *(u32x4*)(out + off + bj * 128) = o; } }
    }
};
struct EpiSwiglu {
    static constexpr bool PERM = true, AFTER_DRAIN = false, CHAIN = false;
    bf16_t* act;
    DI void operator()(const f32x4 (&acc)[2][2][4][2], const pg8::Unit& u, int wr, int wc, int fr, int fq) const {
        const int row0 = u.pm * 256 + wr * 64 + fr, col = u.pn * 128 + wc * 32 + 8 * fq;
#pragma unroll
        for (int ai = 0; ai < 2; ++ai)
#pragma unroll
            for (int m = 0; m < 4; ++m) { const int row = row0 + ai * 128 + m * 16;
                float r[8];
#pragma unroll
                for (int n = 0; n < 2; ++n)
#pragma unroll
                    for (int j = 0; j < 4; ++j) { const float g = acc[ai][0][m][n][j], up = acc[ai][1][m][n][j]; r[4 * n + j] = g * sigmoidf_(g) * up; }
                u32x4 o; o.x = pk2(r[0], r[1]); o.y = pk2(r[2], r[3]); o.z = pk2(r[4], r[5]); o.w = pk2(r[6], r[7]);
                __builtin_nontemporal_store(o, (u32x4*)(act + (size_t)row * DFF_ + col)); }
    }
};

DI void gate_prep(int tid) {
    const int lane = tid & 63, w = tid >> 6; const int nw = gridDim.x * 8;
    unsigned char* const wsp = KWS; const float* bigate = KIN(3); const float* bfgate = KIN(4);
    const float* G16 = (const float*)(wsp + WS_G16);
    float* BC = (float*)(wsp + WS_BC); float* U = (float*)(wsp + WS_U); float* PM = (float*)(wsp + WS_PM);
    for (int id = blockIdx.x * 8 + w; id < 32 * 64; id += nw) {
        const int stream = id >> 6, pc = id & 63; const int dir = stream >> 4, b = (stream >> 2) & 3, h = stream & 3;
        const float bi = bigate[dir * 4 + h], bfg = bfgate[dir * 4 + h];
        float lf[2], ig[2];
#pragma unroll
        for (int e = 0; e < 2; ++e) { const int i = 2 * lane + e; const int p = dir ? 127 - i : i; const size_t tok = (size_t)b * S_ + pc * 128 + p;
            const float gi = G16[tok * 16 + dir * 8 + h] + bi, gf = G16[tok * 16 + dir * 8 + 4 + h] + bfg;
            ig[e] = 15.0f * tanhf(gi * (1.0f / 15.0f));
            const float fc = 15.0f * tanhf(gf * (1.0f / 15.0f));
            lf[e] = fminf(fc, 0.f) - log1pf(expf(-fabsf(fc))); }
        float s = lf[0] + lf[1];
#pragma unroll
        for (int o = 1; o < 64; o <<= 1) { const float t = __shfl_up(s, o); if (lane >= o) s += t; }
        const float b1 = s, b0 = s - lf[1];
        const float u0 = ig[0] - b0, u1 = ig[1] - b1;
        float mx = fmaxf(u0, u1);
#pragma unroll
        for (int o = 1; o < 64; o <<= 1) { const float t = __shfl_up(mx, o); if (lane >= o) mx = fmaxf(mx, t); }
        float mprev = __shfl_up(mx, 1); if (lane == 0) mprev = -INFINITY;
        const float pm0 = fmaxf(mprev, u0), pm1 = mx;
        const size_t base = (size_t)stream * S_ + pc * 128;
        const int p0 = dir ? 127 - 2 * lane : 2 * lane, p1 = dir ? 126 - 2 * lane : 2 * lane + 1;
        BC[base + p0] = b0; BC[base + p1] = b1; U[base + p0] = u0; U[base + p1] = u1; PM[base + p0] = pm0; PM[base + p1] = pm1;
    }
}

DI void mlstm_item(int item, LAS unsigned char* lds, int tid_in) {
    int tid = tid_in; asm volatile("" : "+v"(tid));
    const int lane = tid & 63, w = tid >> 6, fr = lane & 15, fq = lane >> 4;
    const int vs = item & 3, h = (item >> 2) & 3, b = (item >> 4) & 3, dir = item >> 6;
    const int stream = dir * 16 + b * 4 + h;
    constexpr int LD = 136;
    LAS bf16_t* Ks = (LAS bf16_t*)lds; LAS bf16_t* KTs = Ks + 128 * LD; LAS bf16_t* VTs = KTs + 128 * LD; LAS bf16_t* VTw = VTs + 64 * LD; LAS bf16_t* Cs = VTw + 64 * LD;
    LAS float* su = (LAS float*)(Cs + 64 * LD); LAS float* spm = su + 128; LAS float* sbc = su + 256; LAS float* swk = su + 384; LAS float* snl = su + 512; LAS float* sunx = su + 640;
    for (int e = tid; e < 64 * LD / 2; e += 512) ((LAS unsigned*)Cs)[e] = 0u;
    if (tid < 128) snl[tid] = 0.f;
    f32x4 Cacc[4];
#pragma unroll
    for (int i = 0; i < 4; ++i) Cacc[i] = (f32x4){0.f, 0.f, 0.f, 0.f};
    float nreg = 0.f, mcar = 0.f;
    unsigned char* const wsp = KWS;
    const bf16_t* proj = (const bf16_t*)(wsp + WS_PROJ); const bf16_t* xt = (const bf16_t*)(wsp + WS_XT);
    const bf16_t* Qg = proj + h * 128; const bf16_t* Kg = proj + 512 + h * 128;
    const bf16_t* VTg = xt + (size_t)(h * 256 + vs * 64) * T_;
    bf16_t* HX = (bf16_t*)KOUT + (dir ? (size_t)T_ * 1024 : 0) + h * 256 + vs * 64;
    const float* Ug = (const float*)(wsp + WS_U) + (size_t)stream * S_; const float* PMg = (const float*)(wsp + WS_PM) + (size_t)stream * S_; const float* BCg = (const float*)(wsp + WS_BC) + (size_t)stream * S_;
    const int plast = dir ? 0 : 127;
    bf16x8 kreg[4], vtreg[2], Bq[4]; float myu = 0.f, mypm = 0.f, mybc = 0.f, pm_end_n, bL_n;
#define ML_LOAD(CN) do { const int pc_ = dir ? 63 - (CN) : (CN); const int p0_ = pc_ * 128; const size_t tk_ = (size_t)b * S_ + p0_; int tv_ = tid; asm volatile("" : "+v"(tv_)); \
        _Pragma("unroll") for (int i = 0; i < 4; ++i) { const int id = tv_ + 512 * i, r = id >> 4, sg = id & 15; \
            kreg[i] = *(const bf16x8*)(Kg + (tk_ + r) * PLD + sg * 8); } \
        _Pragma("unroll") for (int i = 0; i < 2; ++i) { const int id = tv_ + 512 * i, r = id >> 4, sg = id & 15; vtreg[i] = *(const bf16x8*)(VTg + (size_t)r * T_ + tk_ + sg * 8); } \
        _Pragma("unroll") for (int k = 0; k < 4; ++k) Bq[k] = *(const bf16x8*)(Qg + (tk_ + 16 * w + fr) * PLD + 32 * k + 8 * fq); \
        if (tv_ < 128) { myu = Ug[p0_ + tv_]; mypm = PMg[p0_ + tv_]; mybc = BCg[p0_ + tv_]; } \
        pm_end_n = PMg[p0_ + plast]; bL_n = BCg[p0_ + plast]; } while (0)
    ML_LOAD(0);
    if (tid < 128) sunx[tid] = myu;
    __syncthreads();
    for (int c = 0; c < 64; ++c) {
        const int pc = dir ? 63 - c : c; const int p0 = pc * 128; const size_t tok0 = (size_t)b * S_ + p0;
        const float pm_end = pm_end_n, bL = bL_n;
        const float Mend = fmaxf(mcar, pm_end);
        int tw = tid; asm volatile("" : "+v"(tw));
#pragma unroll
        for (int i = 0; i < 4; ++i) { const int id = tw + 512 * i, r = id >> 4, sg = id & 15; *(LAS bf16x8*)(Ks + r * LD + sg * 8) = kreg[i]; }
#pragma unroll
        for (int i = 0; i < 2; ++i) { const int id = tw + 512 * i, r = id >> 4, sg = id & 15; *(LAS bf16x8*)(VTs + r * LD + sg * 8) = vtreg[i];
            float f[8];
#pragma unroll
            for (int j = 0; j < 8; ++j) f[j] = bf2f((unsigned short)vtreg[i][j]) * __expf(sunx[sg * 8 + j] - Mend);
            *(LAS bf16x8*)(VTw + r * LD + sg * 8) = pack8(f[0], f[1], f[2], f[3], f[4], f[5], f[6], f[7]); }
        if (tid < 128) { su[tid] = myu; spm[tid] = mypm; sbc[tid] = mybc; swk[tid] = __expf(myu - Mend); }
        __syncthreads();
        const int tph = 16 * w + fr;
        int tphv = tph - 4 * fq; asm volatile("" : "+v"(tphv));
        const float Mt = fmaxf(mcar, spm[tph]);
        bf16x8 Pf[4]; float rowsum = 0.f;
#pragma unroll
        for (int kk = 0; kk < 4; ++kk) {
            float pv[8];
#pragma unroll
            for (int hh = 0; hh < 2; ++hh) { const int m = 2 * kk + hh;
                f32x4 a = {0.f, 0.f, 0.f, 0.f};
#pragma unroll
                for (int k = 0; k < 4; ++k) { const bf16x8 A = *(const LAS bf16x8*)(Ks + (16 * m + fr) * LD + 32 * k + 8 * fq); a = MFMA16(A, Bq[k], a); }
                const f32x4 us = *(const LAS f32x4*)(su + 16 * m + 4 * fq);
#pragma unroll
                for (int j = 0; j < 4; ++j) { const int sph = 16 * m + j; const bool ok = dir ? (sph >= tphv) : (sph <= tphv);
                    const float wt = ok ? __expf(us[j] - Mt) : 0.f; const float p = a[j] * wt; pv[4 * hh + j] = p; rowsum += p; }
            }
            Pf[kk] = pack8(pv[0], pv[1], pv[2], pv[3], pv[4], pv[5], pv[6], pv[7]);
        }
        rowsum += __shfl_xor(rowsum, 16); rowsum += __shfl_xor(rowsum, 32);
        f32x4 acc[4];
#pragma unroll
        for (int mv = 0; mv < 4; ++mv) { acc[mv] = (f32x4){0.f, 0.f, 0.f, 0.f};
#pragma unroll
            for (int k = 0; k < 4; ++k) { const bf16x8 A = *(const LAS bf16x8*)(Cs + (16 * mv + fr) * LD + 32 * k + 8 * fq); acc[mv] = MFMA16(A, Bq[k], acc[mv]); } }
        float qn = 0.f;
#pragma unroll
        for (int k = 0; k < 4; ++k) { const f32x4 n0 = *(const LAS f32x4*)(snl + 32 * k + 8 * fq), n1 = *(const LAS f32x4*)(snl + 32 * k + 8 * fq + 4);
#pragma unroll
            for (int j = 0; j < 4; ++j) { qn += bf2f((unsigned short)Bq[k][j]) * n0[j]; qn += bf2f((unsigned short)Bq[k][4 + j]) * n1[j]; } }
        qn += __shfl_xor(qn, 16); qn += __shfl_xor(qn, 32);
        const float at = __expf(mcar - Mt);
        const float den = at * qn + rowsum;
#pragma unroll
        for (int mv = 0; mv < 4; ++mv) acc[mv] *= at;
#pragma unroll
        for (int kk = 0; kk < 4; ++kk)
#pragma unroll
            for (int mv = 0; mv < 4; ++mv) { const LAS bf16_t* vp = VTs + (16 * mv + fr) * LD + 32 * kk + 4 * fq;
                const u32x2 lo = *(const LAS u32x2*)vp, hi = *(const LAS u32x2*)(vp + 16);
                u32x4 av; av.x = lo.x; av.y = lo.y; av.z = hi.x; av.w = hi.y;
                acc[mv] = MFMA16(__builtin_bit_cast(bf16x8, av), Pf[kk], acc[mv]); }
        {
            const float dn = fmaxf(fabsf(den), __expf(-(sbc[tph] + Mt))); const float inv = 1.0f / dn;
            bf16_t* op = HX + (tok0 + tph) * 1024 + 4 * fq;
#pragma unroll
            for (int mv = 0; mv < 4; ++mv) { u32x2 o; o.x = pk2(acc[mv][0] * inv, acc[mv][1] * inv); o.y = pk2(acc[mv][2] * inv, acc[mv][3] * inv); *(u32x2*)(op + 16 * mv) = o; }
        }
        ML_LOAD(c + 1 < 64 ? c + 1 : 63);
        const float decay = __expf(mcar - Mend);
#pragma unroll
        for (int mv = 0; mv < 4; ++mv) Cacc[mv] *= decay;
#pragma unroll
        for (int kk = 0; kk < 4; ++kk) { bf16x8 Bk;
#pragma unroll
            for (int e = 0; e < 8; ++e) Bk[e] = (short)Ks[(32 * kk + 8 * fq + e) * LD + 16 * w + fr];
#pragma unroll
            for (int mv = 0; mv < 4; ++mv) { const bf16x8 A = *(const LAS bf16x8*)(VTw + (16 * mv + fr) * LD + 32 * kk + 8 * fq); Cacc[mv] = MFMA16(A, Bk, Cacc[mv]); } }
        if (tid < 128) { float s = 0.f;
#pragma unroll 8
            for (int sr = 0; sr < 128; ++sr) s += bf2f(Ks[sr * LD + tid]) * swk[sr];
            nreg = decay * nreg + s; }
        if (tid < 128) sunx[tid] = myu;
        __syncthreads();
#pragma unroll
        for (int mv = 0; mv < 4; ++mv)
#pragma unroll
            for (int j = 0; j < 4; ++j) Cs[(16 * mv + 4 * fq + j) * LD + 16 * w + fr] = f2bf(Cacc[mv][j]);
        if (tid < 128) snl[tid] = nreg;
        mcar = bL + Mend;
    }
#undef ML_LOAD
}

DI void attn_item(int item, LAS unsigned char* lds, int tid_in) {
    int tid = tid_in; asm volatile("" : "+v"(tid));
    const int lane = tid & 63, w = tid >> 6, q = lane & 31, hf = lane >> 5;
    const int qt = item & 31, hv = (item >> 5) & 15, b = item >> 9, h = hv >> 1, c = hv & 1;
    constexpr int LDK = 72, BUFE = 64 * LDK + 128 * LDK;
    LAS bf16_t* L = (LAS bf16_t*)lds;
    unsigned char* const wsp = KWS;
    const bf16_t* proj = (const bf16_t*)(wsp + WS_PROJ); const bf16_t* xt = (const bf16_t*)(wsp + WS_XT);
    const size_t tokq = (size_t)b * S_ + qt * 256 + 32 * w + q;
    const bf16_t* Qp = proj + tokq * PLD + 2048 + h * 128 + c * 64;
    bf16x8 Bq[4];
#pragma unroll
    for (int ks = 0; ks < 4; ++ks) Bq[ks] = *(const bf16x8*)(Qp + 16 * ks + 8 * hf);
    const bf16_t* Kp = proj + (size_t)b * S_ * PLD + 3072 + h * 128 + c * 64 + (size_t)(tid >> 3) * PLD + (tid & 7) * 8;
    const bf16_t* Vp0 = xt + (size_t)(1024 + h * 128 + (tid >> 3)) * T_ + (size_t)b * S_ + (tid & 7) * 8;
    const bf16_t* Vp1 = Vp0 + (size_t)64 * T_;
    const int kso = (tid >> 3) * LDK + (tid & 7) * 8, vso0 = 64 * LDK + kso, vso1 = vso0 + 64 * LDK;
    f32x16 O[4];
#pragma unroll
    for (int i = 0; i < 4; ++i)
#pragma unroll
        for (int r = 0; r < 16; ++r) O[i][r] = 0.f;
    float l = 0.f, mu = 0.f;
    f32x16 nmu;
#pragma unroll
    for (int r = 0; r < 16; ++r) nmu[r] = 0.f;
    LAS bf16_t* KB0 = L; LAS bf16_t* KB1 = L + 64 * LDK; LAS bf16_t* VB0 = L + 128 * LDK; LAS bf16_t* VB1 = VB0 + 128 * LDK;
    const int vsa = (tid >> 3) * LDK + 16 * ((tid & 7) >> 1) + 4 * (tid & 1), vsb = vsa + 64 * LDK;
#define ATT_STV(buf, r0, r1) do { const u32x4 a_ = __builtin_bit_cast(u32x4, r0), b_ = __builtin_bit_cast(u32x4, r1); \
        *(LAS u32x2*)((buf) + vsa) = (u32x2){a_.x, a_.y}; *(LAS u32x2*)((buf) + vsa + 8) = (u32x2){a_.z, a_.w}; \
        *(LAS u32x2*)((buf) + vsb) = (u32x2){b_.x, b_.y}; *(LAS u32x2*)((buf) + vsb + 8) = (u32x2){b_.z, b_.w}; } while (0)
    bf16x8 rk, rv0, rv1;
    rk = *(const bf16x8*)Kp; rv0 = *(const bf16x8*)Vp0; rv1 = *(const bf16x8*)Vp1;
    *(LAS bf16x8*)(KB0 + kso) = rk; ATT_STV(VB0, rv0, rv1);
    rk = *(const bf16x8*)(Kp + (size_t)64 * PLD);
    *(LAS bf16x8*)(KB1 + kso) = rk;
    __syncthreads();
    f32x16 sA0, sA1, sB0, sB1;
#define ATT_QK(D0, D1, KB) do { D0 = nmu; D1 = nmu; \
        _Pragma("unroll") for (int ks = 0; ks < 4; ++ks) { const bf16x8 A0_ = *(const LAS bf16x8*)((KB) + q * LDK + 16 * ks + 8 * hf); D0 = MFMA32(A0_, Bq[ks], D0); } \
        _Pragma("unroll") for (int ks = 0; ks < 4; ++ks) { const bf16x8 A1_ = *(const LAS bf16x8*)((KB) + (32 + q) * LDK + 16 * ks + 8 * hf); D1 = MFMA32(A1_, Bq[ks], D1); } } while (0)
#define ATT_MAX3(d, a, b, c) asm("v_max3_f32 %0, %1, %2, %3" : "=v"(d) : "v"(a), "v"(b), "v"(c))
#define ATT_TMAX(C0, C1, TM) do { float m0_, m1_; ATT_MAX3(m0_, C0[0], C0[1], C0[2]); ATT_MAX3(m1_, C1[0], C1[1], C1[2]); \
        ATT_MAX3(m0_, m0_, C0[3], C0[4]); ATT_MAX3(m1_, m1_, C1[3], C1[4]); ATT_MAX3(m0_, m0_, C0[5], C0[6]); ATT_MAX3(m1_, m1_, C1[5], C1[6]); \
        ATT_MAX3(m0_, m0_, C0[7], C0[8]); ATT_MAX3(m1_, m1_, C1[7], C1[8]); ATT_MAX3(m0_, m0_, C0[9], C0[10]); ATT_MAX3(m1_, m1_, C1[9], C1[10]); \
        ATT_MAX3(m0_, m0_, C0[11], C0[12]); ATT_MAX3(m1_, m1_, C1[11], C1[12]); ATT_MAX3(m0_, m0_, C0[13], C0[14]); ATT_MAX3(m1_, m1_, C1[13], C1[14]); \
        ATT_MAX3(TM, m0_, m1_, C0[15]); TM = fmaxf(TM, C1[15]); TM = fmaxf(TM, __shfl_xor(TM, 32)); } while (0)
#define ATT_RESCALE(C0, C1, N0, N1, TM, FIRST) do { \
        const float delta_ = (FIRST) ? (TM) : fmaxf((TM), 0.f); \
        const float al_ = (FIRST) ? 1.0f : __builtin_amdgcn_exp2f(-delta_); \
        l *= al_; mu += delta_; \
        _Pragma("unroll") for (int i = 0; i < 4; ++i) O[i] *= al_; \
        _Pragma("unroll") for (int r = 0; r < 16; ++r) { C0[r] -= delta_; C1[r] -= delta_; N0[r] -= delta_; N1[r] -= delta_; nmu[r] = -mu; } } while (0)
#define ATT_GROUP(CM, MT, J, VB) do { float pv_[8]; \
        _Pragma("unroll") for (int e = 0; e < 8; ++e) { pv_[e] = __builtin_amdgcn_exp2f(CM[8 * (J) + e]); l += pv_[e]; } \
        const bf16x8 Pf_ = pack8(pv_[0], pv_[1], pv_[2], pv_[3], pv_[4], pv_[5], pv_[6], pv_[7]); \
        _Pragma("unroll") for (int mv = 0; mv < 4; ++mv) { const bf16x8 Av_ = *(const LAS bf16x8*)((VB) + (32 * mv + q) * LDK + 32 * (MT) + 16 * (J) + 8 * hf); O[mv] = MFMA32(Av_, Pf_, O[mv]); } } while (0)
#define ATT_SOFTPV(C0, C1, N0, N1, VC) do { float tm_; ATT_TMAX(C0, C1, tm_); \
        if (__builtin_expect(__any(tm_ > 8.0f), 0)) ATT_RESCALE(C0, C1, N0, N1, tm_, false); \
        ATT_GROUP(C0, 0, 0, VC); ATT_GROUP(C0, 0, 1, VC); ATT_GROUP(C1, 1, 0, VC); ATT_GROUP(C1, 1, 1, VC); } while (0)
#define ATT_STAGE(T, KW, VW) do { *(LAS bf16x8*)((KW) + kso) = rk; ATT_STV(VW, rv0, rv1); \
        __syncthreads(); \
        { const int tk_ = ((T) + 3 < 128) ? (T) + 3 : 127, tv_ = ((T) + 2 < 128) ? (T) + 2 : 127; \
          rk = *(const bf16x8*)(Kp + (size_t)tk_ * 64 * PLD); rv0 = *(const bf16x8*)(Vp0 + tv_ * 64); rv1 = *(const bf16x8*)(Vp1 + tv_ * 64); } } while (0)
#define ATT_ITER(T, C0, C1, N0, N1, KN, VC, KW, VW) do { ATT_QK(N0, N1, KN); ATT_SOFTPV(C0, C1, N0, N1, VC); ATT_STAGE(T, KW, VW); } while (0)
    ATT_QK(sA0, sA1, KB0);
    { float tm_ = fmaxf(sA0[0], sA1[0]);
#pragma unroll
      for (int r = 1; r < 16; ++r) tm_ = fmaxf(tm_, fmaxf(sA0[r], sA1[r]));
      tm_ = fmaxf(tm_, __shfl_xor(tm_, 32)); mu = tm_;
#pragma unroll
      for (int r = 0; r < 16; ++r) { sA0[r] -= tm_; sA1[r] -= tm_; nmu[r] = -tm_; } }
    rk = *(const bf16x8*)(Kp + (size_t)2 * 64 * PLD); rv0 = *(const bf16x8*)(Vp0 + 64); rv1 = *(const bf16x8*)(Vp1 + 64);
    ATT_QK(sB0, sB1, KB1);
    __syncthreads();
    ATT_GROUP(sA0, 0, 0, VB0); ATT_GROUP(sA0, 0, 1, VB0); ATT_GROUP(sA1, 1, 0, VB0); ATT_GROUP(sA1, 1, 1, VB0);
    ATT_STAGE(0, KB0, VB1);
    for (int t = 1; t < 127; t += 2) {
        ATT_ITER(t, sB0, sB1, sA0, sA1, KB0, VB1, KB1, VB0);
        ATT_ITER(t + 1, sA0, sA1, sB0, sB1, KB1, VB0, KB0, VB1);
    }
    ATT_SOFTPV(sB0, sB1, sA0, sA1, VB1);
    __syncthreads();
#undef ATT_QK
#undef ATT_MAX3
#undef ATT_TMAX
#undef ATT_RESCALE
#undef ATT_GROUP
#undef ATT_SOFTPV
#undef ATT_STAGE
#undef ATT_ITER
#undef ATT_STV
    l += __shfl_xor(l, 32);
    const float inv = 1.0f / l;
    bf16_t* op = (bf16_t*)(wsp + WS_RA) + tokq * 2048 + hv * 128 + 4 * hf;
#pragma unroll
    for (int mv = 0; mv < 4; ++mv)
#pragma unroll
        for (int g = 0; g < 4; ++g) { u32x2 o; o.x = pk2(O[mv][4 * g] * inv, O[mv][4 * g + 1] * inv); o.y = pk2(O[mv][4 * g + 2] * inv, O[mv][4 * g + 3] * inv); *(u32x2*)(op + 32 * mv + 8 * g) = o; }
}

DI void unpack16(const u32x4& lo, const u32x4& hi, float (&v)[16]) {
    v[0] = bflo(lo.x); v[1] = bfhi(lo.x); v[2] = bflo(lo.y); v[3] = bfhi(lo.y); v[4] = bflo(lo.z); v[5] = bfhi(lo.z); v[6] = bflo(lo.w); v[7] = bfhi(lo.w);
    v[8] = bflo(hi.x); v[9] = bfhi(hi.x); v[10] = bflo(hi.y); v[11] = bfhi(hi.y); v[12] = bflo(hi.z); v[13] = bfhi(hi.z); v[14] = bflo(hi.w); v[15] = bfhi(hi.w);
}
DI void store16(bf16_t* p, const float (&o)[16]) {
    u32x4 o0, o1; o0.x = pk2(o[0], o[1]); o0.y = pk2(o[2], o[3]); o0.z = pk2(o[4], o[5]); o0.w = pk2(o[6], o[7]); o1.x = pk2(o[8], o[9]); o1.y = pk2(o[10], o[11]); o1.z = pk2(o[12], o[13]); o1.w = pk2(o[14], o[15]);
    *(u32x4*)p = o0; *(u32x4*)(p + 8) = o1;
}
DI void p3_headnorm(int tid) {
    const int lane = tid & 63, w = tid >> 6; const int nw = gridDim.x * 8;
    unsigned char* const wsp = KWS;
    const bf16_t* HF = (const bf16_t*)KOUT; const bf16_t* HB = HF + (size_t)T_ * 1024; const bf16_t* OA = (const bf16_t*)(wsp + WS_RA);
    const bf16_t* proj = (const bf16_t*)(wsp + WS_PROJ);
    bf16_t* HMG = (bf16_t*)(wsp + WS_XT); bf16_t* HAN = HMG + (size_t)T_ * 1024;
    const float lam = *(const float*)(wsp + WS_MISC + 64);
    const float* mw = KIN(6); const float* aw = KIN(11);
    const int col = (lane >> 4) * 256 + (lane & 15) * 16;
    const int hd = lane >> 3, vo = (lane & 7) * 16;
    for (int tp = blockIdx.x * 8 + w; tp < T_ / 2; tp += nw) {
        u32x4 f[2][2], bb[2][2], g[2][2], a[2][2], c[2][2];
#pragma unroll
        for (int h = 0; h < 2; ++h) { const size_t t = (size_t)(2 * tp + h);
            f[h][0] = *(const u32x4*)(HF + t * 1024 + col); f[h][1] = *(const u32x4*)(HF + t * 1024 + col + 8);
            bb[h][0] = *(const u32x4*)(HB + t * 1024 + col); bb[h][1] = *(const u32x4*)(HB + t * 1024 + col + 8);
            g[h][0] = *(const u32x4*)(proj + t * PLD + 1024 + col); g[h][1] = *(const u32x4*)(proj + t * PLD + 1024 + col + 8);
            const bf16_t* p0 = OA + t * 2048 + (2 * hd) * 128 + vo;
            a[h][0] = *(const u32x4*)p0; a[h][1] = *(const u32x4*)(p0 + 8); c[h][0] = *(const u32x4*)(p0 + 128); c[h][1] = *(const u32x4*)(p0 + 136); }
#pragma unroll
        for (int h = 0; h < 2; ++h) { const size_t t = (size_t)(2 * tp + h);
            {
                float vf[16], vb[16], gt[16], v[16], o[16];
                unpack16(f[h][0], f[h][1], vf); unpack16(bb[h][0], bb[h][1], vb); unpack16(g[h][0], g[h][1], gt);
                float s = 0.f;
#pragma unroll
                for (int i = 0; i < 16; ++i) { v[i] = vf[i] + vb[i]; s += v[i] * v[i]; }
                s += __shfl_xor(s, 1); s += __shfl_xor(s, 2); s += __shfl_xor(s, 4); s += __shfl_xor(s, 8);
                const float r = rsqrtf(s * (1.0f / 256.0f) + EPS_);
#pragma unroll
                for (int i = 0; i < 16; ++i) o[i] = v[i] * r * mw[col + i] * gt[i];
                store16(HMG + t * 1024 + col, o);
            }
            {
                float va[16], vc[16], v[16], o[16];
                unpack16(a[h][0], a[h][1], va); unpack16(c[h][0], c[h][1], vc);
                float s = 0.f;
#pragma unroll
                for (int i = 0; i < 16; ++i) { v[i] = va[i] - lam * vc[i]; s += v[i] * v[i]; }
                s += __shfl_xor(s, 1); s += __shfl_xor(s, 2); s += __shfl_xor(s, 4);
                const float r = rsqrtf(s * (1.0f / 128.0f) + EPS_) * 0.8f;
#pragma unroll
                for (int i = 0; i < 16; ++i) o[i] = v[i] * r * aw[vo + i];
                store16(HAN + t * 1024 + hd * 128 + vo, o);
            }
        }
    }
}

#define XB_TMO      128
#define XB_XCNT(j)  (256  + 64 * (j))
#define XB_XSUB(j)  (1280 + 64 * (j))
#define XB_XGEN(j)  (2304 + 64 * (j))
#define XB_TOP      3328
#define XB_TOPGEN   3392
#define XCD_BAR_WORDS 3456
#define XB_SPIN_CAP (1u << 18)

__device__ __forceinline__ unsigned xb_ld(unsigned* p)              { return __hip_atomic_load(p, __ATOMIC_RELAXED, __HIP_MEMORY_SCOPE_AGENT); }
__device__ __forceinline__ unsigned xb_add(unsigned* p, unsigned v) { return __hip_atomic_fetch_add(p, v, __ATOMIC_RELAXED, __HIP_MEMORY_SCOPE_AGENT); }
__device__ __forceinline__ unsigned xb_xcc_id() { return (unsigned)__builtin_amdgcn_s_getreg((3 << 11) | 20) & 0xFu; }
#define XB_SPIN(cond, bar) do { unsigned _sp = 0; while (cond) { __builtin_amdgcn_s_sleep(1); \
    if ((++_sp & 255u) == 0u) { if (xb_ld(&(bar)[XB_TMO])) break; if (_sp > XB_SPIN_CAP) { atomicAdd(&(bar)[XB_TMO], 1u); break; } } } } while (0)

struct XcdBarrier {
    unsigned* bar; unsigned x;
    volatile LAS unsigned* st;
};

__device__ __forceinline__ XcdBarrier xcd_barrier_post(unsigned* bar, volatile LAS unsigned* st) {
    XcdBarrier b; b.bar = bar; b.x = xb_xcc_id(); b.st = st;
    if (threadIdx.x == 0) (void)xb_add(&bar[XB_XCNT(b.x)], 1u);
    return b;
}
__device__ __forceinline__ void xcd_barrier_complete(unsigned* bar, unsigned x, unsigned& nloc, unsigned& nx) {
    const unsigned G = gridDim.x * gridDim.y * gridDim.z;
    unsigned sum, cnt, mine, sp = 0u;
    for (;;) {
        sum = 0u; cnt = 0u; mine = 0u;
#pragma unroll
        for (unsigned j = 0; j < 16; ++j) { const unsigned c = xb_ld(&bar[XB_XCNT(j)]); sum += c; cnt += (c > 0u) ? 1u : 0u; mine = (j == x) ? c : mine; }
        if (sum == G) break;
        __builtin_amdgcn_s_sleep(1);
        if ((++sp & 255u) == 0u) { if (xb_ld(&bar[XB_TMO])) break; if (sp > XB_SPIN_CAP) { atomicAdd(&bar[XB_TMO], 1u); break; } }
    }
    nloc = mine > 0u ? mine : 1u; nx = cnt > 0u ? cnt : 1u;
}

__device__ __forceinline__ void xcd_barrier(const XcdBarrier& b) {
    asm volatile("s_waitcnt vmcnt(0)" ::: "memory");
    __syncthreads();
    if (threadIdx.x == 0) {
        unsigned* bar = b.bar;
        __builtin_amdgcn_s_waitcnt(0);
        unsigned nloc = b.st[0], nx = b.st[1];
        if (nloc == 0u) { xcd_barrier_complete(bar, b.x, nloc, nx); b.st[0] = nloc; b.st[1] = nx; }
        const unsigned old = xb_add(&bar[XB_XSUB(b.x)], 1u);
        const unsigned gen = old / nloc;
        if (old + 1u == (gen + 1u) * nloc) {
            __builtin_amdgcn_fence(__ATOMIC_RELEASE, "agent");
            asm volatile("s_waitcnt vmcnt(0)" ::: "memory");
            const unsigned og = xb_add(&bar[XB_TOP], 1u);
            const unsigned tg = og / nx;
            if (og + 1u == (tg + 1u) * nx) xb_add(&bar[XB_TOPGEN], 1u);
            else XB_SPIN(xb_ld(&bar[XB_TOPGEN]) == tg, bar);
            __builtin_amdgcn_fence(__ATOMIC_ACQUIRE, "agent");
            xb_add(&bar[XB_XGEN(b.x)], 1u);
            asm volatile("s_waitcnt vmcnt(0)" ::: "memory");
        } else {
            XB_SPIN(xb_ld(&bar[XB_XGEN(b.x)]) == gen, bar);
            __builtin_amdgcn_fence(__ATOMIC_ACQUIRE, "agent");
            asm volatile("s_waitcnt vmcnt(0)" ::: "memory");
        }
    }
    __syncthreads();
}


__global__ void __launch_bounds__(512) fwd_mega(Params Punused) {
    extern __shared__ __attribute__((aligned(16))) unsigned char lds_raw[];
    LAS unsigned char* lds = (LAS unsigned char*)lds_raw;
    cg::grid_group grid = cg::this_grid();
    { LAS unsigned* xw = (LAS unsigned*)(lds + LDS_STAGE + 16); if (threadIdx.x < 2) xw[threadIdx.x] = 0u; __syncthreads(); }
    const int G = gridDim.x, bx = blockIdx.x;
    unsigned char* ws = KWS;
    unsigned* counter = (unsigned*)(ws + WS_MISC);
    bf16_t* const H = (bf16_t*)(ws + WS_RA);
    bf16_t* const PROJ = (bf16_t*)(ws + WS_PROJ);
    bf16_t* const XT = (bf16_t*)(ws + WS_XT);

    for (int rep = 0; rep < REP_P0; ++rep) {
        const int tid = fresh_tid();
        int total = 0;
        for (int i = 0; i < NREG; ++i) total += c_regs[i].ngroups * (c_regs[i].K >> 6);
        conv_units(bx, total, G, (LAS float*)lds, tid);
        p0_norm_gates((LAS float*)lds, tid);
        float* cosT = (float*)(ws + WS_COS); float* sinT = (float*)(ws + WS_SIN);
        for (int idx = bx * 512 + tid; idx < S_ * 32; idx += G * 512) {
            const int pos = idx >> 5, j = idx & 31; const float ang = (float)pos * c_inv[j];
            const double rev = (double)ang * 0.15915494309189535; const float f = (float)(rev - rint(rev));
            cosT[idx] = __builtin_amdgcn_cosf(f); sinT[idx] = __builtin_amdgcn_sinf(f);
        }
        if (bx == 0) { unsigned* bw = (unsigned*)(ws + WS_BAR); for (int q = tid; q < XCD_BAR_WORDS; q += 512) bw[q] = 0u; }
        if (bx == 0 && tid == 0) {
            counter[0] = 0u; counter[1] = 0u; counter[2] = 0u; counter[3] = 0u;
            float d1 = 0.f, d2 = 0.f;
            const float* l1 = KIN(7); const float* l2 = KIN(8); const float* l3 = KIN(9); const float* l4 = KIN(10);
            for (int i = 0; i < 64; ++i) { d1 += l1[i] * l2[i]; d2 += l3[i] * l4[i]; }
            *(float*)(ws + WS_MISC + 64) = expf(d1) - expf(d2) + 0.2f;
        }
    }
    grid.sync();
    const XcdBarrier xbar = xcd_barrier_post((unsigned*)(KWS + WS_BAR), (volatile LAS unsigned*)(lds + LDS_STAGE + 16));
    for (int rep = 0; rep < REP_P1; ++rep) {
        gate_prep(fresh_tid());
        { pg8::Gemm g{H, (const bf16_t*)(ws + WS_W1T), T_, 8192, 2048}; pg8::StaticOrder S; S.init(T_, 8192, G, bx);
          EpiMain E{PROJ, (bf16_t*)(ws + WS_GT), KIN(5), (const float*)(ws + WS_COS), (const float*)(ws + WS_SIN)};
          pg8::gemm_phase<EpiMain, pg8::StaticOrder, false>(lds, g, S, E, nullptr); }
        { pg8::Gemm g{(const bf16_t*)(ws + WS_W2T), H, 2048, T_, 2048}; pg8::StaticOrder S; S.init(2048, T_, G, bx);
          EpiPlain E{XT, T_};
          pg8::gemm_phase<EpiPlain, pg8::StaticOrder, false>(lds, g, S, E, nullptr); }
    }
    xcd_barrier(xbar);
    for (int rep = 0; rep < REP_P2; ++rep) {
        if (rep) grid.sync();
        unsigned* counter = (unsigned*)(ws + WS_MISC) + rep;
        const int tid = fresh_tid();
        LAS int* qw = (LAS int*)(lds + LDS_STAGE);
#define GRAB(dst) do { if (tid == 0) *qw = (int)atomicAdd(counter, 1u); __syncthreads(); dst = *qw; __syncthreads(); } while (0)
        int item; GRAB(item);
#ifndef NO_MLSTM
        while (item < N_MLSTM_ITEMS) { mlstm_item(item, lds, tid); GRAB(item); }
#endif
#ifndef NO_ATTN
        while (item < N_MLSTM_ITEMS + N_ATTN_ITEMS) { attn_item(item - N_MLSTM_ITEMS, lds, tid); GRAB(item); }
#endif
#undef GRAB
    }
    xcd_barrier(xbar);
    for (int rep = 0; rep < REP_P3; ++rep) p3_headnorm(fresh_tid());
    xcd_barrier(xbar);
    for (int rep = 0; rep < REP_P4; ++rep) {
        pg8::Gemm g{XT, (const bf16_t*)(ws + WS_WBM), 2 * T_, 4096, 1024}; BranchOrder S; S.init(T_, 2048, G, bx);
        EpiBranchChain E{(const bf16_t*)(ws + WS_GT), H}; pg8::gemm_phase<EpiBranchChain, BranchOrder, false>(lds, g, S, E, nullptr);
    }
    xcd_barrier(xbar);
    for (int rep = 0; rep < REP_P5; ++rep) {
        pg8::Gemm g{H, (const bf16_t*)(ws + WS_WOUT), T_, 2048, 2048}; pg8::StaticOrder S; S.init(T_, 2048, G, bx);
        EpiResidBf E{KIN(0), XT}; pg8::gemm_phase<EpiResidBf, pg8::StaticOrder, false>(lds, g, S, E, nullptr);
    }
    xcd_barrier(xbar);
    for (int rep = 0; rep < REP_P6; ++rep) rows_rmsnorm_bf<true>(XT, KIN(15), H, nullptr, fresh_tid());
    xcd_barrier(xbar);
    for (int rep = 0; rep < REP_P7; ++rep) {
        pg8::Gemm g{H, (const bf16_t*)(ws + WS_WFFI), T_, 2 * DFF_, 2048}; pg8::StaticOrder S; S.init(T_, 2 * DFF_, G, bx);
        EpiSwiglu E{PROJ}; pg8::gemm_phase<EpiSwiglu, pg8::StaticOrder, false>(lds, g, S, E, nullptr);
    }
    xcd_barrier(xbar);
    if (!SKIP_P8) {
        pg8::Gemm g{PROJ, (const bf16_t*)(ws + WS_WFFO), T_, 2048, DFF_}; pg8::StaticOrder S; S.init(T_, 2048, G, bx);
        EpiResidBfBf E{XT, (bf16_t*)(ws + WS_X2)}; pg8::gemm_phase<EpiResidBfBf, pg8::StaticOrder, false>(lds, g, S, E, nullptr);
    }
    xcd_barrier(xbar);
    if (!SKIP_P9) rows_rmsnorm_bf<false>((const bf16_t*)(ws + WS_X2), KIN(18), nullptr, KOUT, fresh_tid());
}

extern "C" void kernel_launch(void* const* d_in, const int* in_sizes, int n_in, void* d_out, int out_size, void* d_ws, size_t ws_size, hipStream_t stream) {
    static int grid_blocks = 0;
    if (!grid_blocks) {
        int dev = 0, cus = 0, per_cu = 0;
        (void)hipGetDevice(&dev);
        (void)hipDeviceGetAttribute(&cus, hipDeviceAttributeMultiprocessorCount, dev);
        (void)hipFuncSetAttribute((const void*)fwd_mega, hipFuncAttributeMaxDynamicSharedMemorySize, LDS_BYTES);
        (void)hipOccupancyMaxActiveBlocksPerMultiprocessor(&per_cu, (const void*)fwd_mega, 512, LDS_BYTES);
        if (per_cu < 1) per_cu = 1;
        grid_blocks = cus * per_cu;
        if (n_in != 19 || ws_size < 940 * MIB) fprintf(stderr, "kernel_launch: unexpected n_in %d / ws_size %zu\n", n_in, ws_size);
    }
    Params p{};
    for (int i = 0; i < 19; ++i) p.in[i] = (const float*)d_in[i];
    p.out = (float*)d_out; p.ws = (unsigned char*)d_ws;
    void* args[] = {&p};
    hipError_t e = hipLaunchCooperativeKernel((const void*)fwd_mega, dim3(grid_blocks), dim3(512), args, LDS_BYTES, stream);
    if (e != hipSuccess) fprintf(stderr, "cooperative launch failed: %s (grid %d)\n", hipGetErrorString(e), grid_blocks);
}
```

```cpp
#include <hip/hip_runtime.h>
#include <hip/hip_cooperative_groups.h>
#include <cstdio>
namespace cg = cooperative_groups;
namespace pg8 {
#define PG8_LAS __attribute__((address_space(3)))
typedef unsigned short bf16_t;
typedef short bf16x8 __attribute__((ext_vector_type(8)));
typedef float f32x4 __attribute__((ext_vector_type(4)));
typedef unsigned u32x4 __attribute__((ext_vector_type(4)));
constexpr int BM = 256, BK = 64, HALF = 128, HTB = HALF * BK * 2  , STAGE_BYTES = 8 * HTB, NXCD = 8, WGM = 8;

__host__ __device__ __forceinline__ int lds_byte(int r, int c) { const int st = (r >> 4) * 2 + (c >> 5), rr = r & 15, cc = c & 31, ob = rr * 64 + cc * 2; return st * 1024 + (ob ^ (((ob >> 9) & 1) << 5)); }
__host__ __device__ __forceinline__ void stage_rc(int b, int& R, int& C) { const int st = b / 1024, sb = b % 1024, swz = sb ^ (((sb >> 9) & 1) << 5); R = (st >> 1) * 16 + swz / 64; C = (st & 1) * 32 + (swz % 64) / 2; }
__host__ __device__ __forceinline__ int perm32(int rho) { const int n = rho >> 4, i = rho & 15; return 8 * (i >> 2) + 4 * n + (i & 3); }

struct Unit { int pm, pn; };
struct Gemm { const bf16_t* A; const bf16_t* Bt; int M, N, K; };

struct StaticOrder {
    int nM, nN, nwg, G, c;
    __host__ __device__ void init(int M, int N, int G_, int c_) { nM = M / BM; nN = N / BM; nwg = nM * nN; G = G_; c = c_; }
    __host__ __device__ bool next(int i, Unit& u) const {
        const long L = (long)i * G + c; if (L >= nwg) return false;
        int wgid = (int)L; { const int q = nwg / NXCD, r = nwg % NXCD, xcd = wgid % NXCD, off = wgid / NXCD; wgid = (xcd < r ? xcd * (q + 1) : r * (q + 1) + (xcd - r) * q) + off; }
        const int nig = WGM * nN, gid = wgid / nig, fm = gid * WGM, gsz = (nM - fm) < WGM ? (nM - fm) : WGM;
        u.pm = fm + ((wgid % nig) % gsz); u.pn = (wgid % nig) / gsz; return true;
    }
    __device__ __forceinline__ void a_ready(const Unit&) const {}
    __device__ __forceinline__ void done(const Unit&) const {}
};
__device__ __forceinline__ unsigned cvt_pk_bf16(float lo, float hi) { unsigned r; asm volatile("v_cvt_pk_bf16_f32 %0, %1, %2" : "=v"(r) : "v"(lo), "v"(hi)); return r; }
typedef float f32x2 __attribute__((ext_vector_type(2)));
template <class Epi, class Sched, bool STAMP = false>
__device__ __forceinline__ void gemm_phase(PG8_LAS unsigned char* lds, const Gemm g, const Sched& S, const Epi& E, unsigned long long* stamps) {
    int tid_ = threadIdx.x; asm volatile("" : "+v"(tid_));
    const int tid = tid_, wid = __builtin_amdgcn_readfirstlane(tid >> 6), lane = tid & 63, wr = wid >> 2, wc = wid & 3, fr = lane & 15, fq = lane >> 4;
    const int K = g.K, nt = K / BK;
    int ts_lo = 0, ts_hi = 0, nts = 0; const unsigned long long rt_entry = STAMP ? (unsigned long long)wall_clock64() : 0ull;
#define PG8_STAMP() do { if (STAMP && wid == 0 && nts < 64) { const unsigned long long _c = (unsigned long long)clock64(); \
        ts_lo = (lane == nts) ? (int)(unsigned)_c : ts_lo; ts_hi = (lane == nts) ? (int)(unsigned)(_c >> 32) : ts_hi; ++nts; } } while (0)
    PG8_STAMP();
    unsigned voffA[2], voffB[2];
#pragma unroll
    for (int i = 0; i < 2; ++i) { int R, C; stage_rc(tid * 16 + i * 8192, R, C); const int Rb = Epi::PERM ? ((R & ~31) + perm32(R & 31)) : R;
        voffA[i] = (unsigned)(R * K + C) * 2u; voffB[i] = (unsigned)(Rb * K + C) * 2u; }
    const size_t kstep = (size_t)(BK * 2);
    const size_t hstep = (size_t)HALF * K * 2;
    const size_t tstep = 2 * hstep;
    const unsigned ldsw = (unsigned)wid * 1024u;
    const int aoff = lds_byte(wr * 64 + fr, fq * 8), boff = lds_byte(wc * 32 + fr, fq * 8);
#define PG8_SA(b, h) (((b) * 2 + (h)) * HTB)
#define PG8_SB(b, h) ((4 + (b) * 2 + (h)) * HTB)
#define PG8_STAGE(bufoff, gbase, voff) do { _Pragma("unroll") for (int _i = 0; _i < 2; ++_i) \
        __builtin_amdgcn_global_load_lds((const unsigned*)((const char*)(gbase) + (voff)[_i]), (PG8_LAS unsigned*)(lds + (bufoff) + ldsw + _i * 8192), 16, 0, 0); } while (0)
#define PG8_LDA(dst, b, h) do { _Pragma("unroll") for (int m = 0; m < 4; ++m) _Pragma("unroll") for (int k = 0; k < 2; ++k) dst[m][k] = *(const PG8_LAS bf16x8*)(lds + PG8_SA(b, h) + aoff + m * 2048 + k * 1024); } while (0)
#define PG8_LDB(dst, b, h) do { _Pragma("unroll") for (int n = 0; n < 2; ++n) _Pragma("unroll") for (int k = 0; k < 2; ++k) dst[n][k] = *(const PG8_LAS bf16x8*)(lds + PG8_SB(b, h) + boff + n * 2048 + k * 1024); } while (0)
#define PG8_MMA(ai, bj, At, Bt) do { __builtin_amdgcn_s_setprio(1); _Pragma("unroll") for (int m = 0; m < 4; ++m) _Pragma("unroll") for (int n = 0; n < 2; ++n) _Pragma("unroll") for (int k = 0; k < 2; ++k) \
        acc[ai][bj][m][n] = __builtin_amdgcn_mfma_f32_16x16x32_bf16(Bt[n][k], At[m][k], acc[ai][bj][m][n], 0, 0, 0); __builtin_amdgcn_s_setprio(0); } while (0)
#define PG8_WAIT_V(n) asm volatile("s_waitcnt vmcnt(" #n ")" ::: "memory")
#define PG8_WAIT_L(n) asm volatile("s_waitcnt lgkmcnt(" #n ")" ::: "memory")
#define PG8_BAR __builtin_amdgcn_s_barrier()
#define PG8_SCHED __builtin_amdgcn_sched_barrier(0)
    Unit cur, nxt; int ui = 0;
    if (!S.next(0, cur)) return;
    f32x4 acc[2][2][4][2];
#pragma unroll
    for (int a = 0; a < 2; ++a)
#pragma unroll
        for (int b = 0; b < 2; ++b)
#pragma unroll
            for (int m = 0; m < 4; ++m)
#pragma unroll
                for (int n = 0; n < 2; ++n) acc[a][b][m][n] = (f32x4){0.f, 0.f, 0.f, 0.f};
    bf16x8 At[4][2], B0[2][2], B1[2][2];
    const char* cA = (const char*)g.A + (size_t)cur.pm * tstep; const char* cB = (const char*)g.Bt + (size_t)cur.pn * tstep;
    S.a_ready(cur);
    PG8_STAGE(PG8_SB(0, 0), cB, voffB); PG8_STAGE(PG8_SA(0, 0), cA, voffA); PG8_STAGE(PG8_SB(0, 1), cB + hstep, voffB); PG8_STAGE(PG8_SA(0, 1), cA + hstep, voffA);
    if (wr == 1) PG8_BAR;
    PG8_WAIT_V(4); PG8_BAR;
    PG8_STAGE(PG8_SB(1, 0), cB + kstep, voffB); PG8_STAGE(PG8_SA(1, 0), cA + kstep, voffA); PG8_STAGE(PG8_SB(1, 1), cB + hstep + kstep, voffB);
    PG8_WAIT_V(6); PG8_BAR;
    PG8_STAMP();
    for (;;) {
        const bool has_next = S.next(ui + 1, nxt);
        const char* nA = has_next ? (const char*)g.A + (size_t)nxt.pm * tstep : cA; const char* nB = has_next ? (const char*)g.Bt + (size_t)nxt.pn * tstep : cB;
        for (int t = 0; t < nt; t += 2) {
            const bool last = (t == nt - 2);
            const char* a1 = cA + (size_t)(t + 1) * kstep;
            const char* a2 = last ? nA : cA + (size_t)(t + 2) * kstep; const char* b2 = last ? nB : cB + (size_t)(t + 2) * kstep;
            const char* a3 = a2 + kstep; const char* b3 = b2 + kstep;
            if (last && has_next) S.a_ready(nxt);
            PG8_LDB(B0, 0, 0); PG8_SCHED; PG8_LDA(At, 0, 0); PG8_STAGE(PG8_SA(1, 1), a1 + hstep, voffA);
            PG8_WAIT_L(8); PG8_BAR; PG8_WAIT_L(0); PG8_MMA(0, 0, At, B0); PG8_BAR; PG8_SCHED;
            PG8_LDB(B1, 0, 1); PG8_STAGE(PG8_SB(0, 0), b2, voffB);
            PG8_BAR; PG8_WAIT_L(0); PG8_MMA(0, 1, At, B1); PG8_BAR;
            PG8_LDA(At, 0, 1); PG8_STAGE(PG8_SA(0, 0), a2, voffA);
            PG8_BAR; PG8_WAIT_L(0); PG8_MMA(1, 0, At, B0); PG8_BAR; PG8_SCHED;
            PG8_STAGE(PG8_SB(0, 1), b2 + hstep, voffB);
            PG8_WAIT_V(6); PG8_BAR; PG8_MMA(1, 1, At, B1); PG8_BAR;
            PG8_LDB(B0, 1, 0); PG8_SCHED; PG8_LDA(At, 1, 0); PG8_STAGE(PG8_SA(0, 1), a2 + hstep, voffA);
            PG8_WAIT_L(8); PG8_BAR; PG8_WAIT_L(0); PG8_MMA(0, 0, At, B0); PG8_BAR; PG8_SCHED;
            PG8_LDB(B1, 1, 1); PG8_STAGE(PG8_SB(1, 0), b3, voffB);
            PG8_BAR; PG8_WAIT_L(0); PG8_MMA(0, 1, At, B1); PG8_BAR;
            PG8_LDA(At, 1, 1); PG8_STAGE(PG8_SA(1, 0), a3, voffA);
            PG8_BAR; PG8_WAIT_L(0); PG8_MMA(1, 0, At, B0); PG8_BAR; PG8_SCHED;
            PG8_STAGE(PG8_SB(1, 1), b3 + hstep, voffB);
            PG8_WAIT_V(6); PG8_BAR; PG8_MMA(1, 1, At, B1); PG8_BAR;
        }
        PG8_STAMP();
        bool keep_acc = false;
        if constexpr (Epi::CHAIN) { keep_acc = E.chain(acc, cur, wr, wc, fr, fq); } else if constexpr (!Epi::AFTER_DRAIN) { E(acc, cur, wr, wc, fr, fq); S.done(cur); }
        PG8_STAMP();
        if (!has_next) break;
        if (!keep_acc)
#pragma unroll
        for (int a = 0; a < 2; ++a)
#pragma unroll
            for (int b = 0; b < 2; ++b)
#pragma unroll
                for (int m = 0; m < 4; ++m)
#pragma unroll
                    for (int n = 0; n < 2; ++n) acc[a][b][m][n] = (f32x4){0.f, 0.f, 0.f, 0.f};
        cur = nxt; cA = nA; cB = nB; ++ui;
    }
    PG8_WAIT_V(0);
    if (wr == 0) PG8_BAR;
    PG8_BAR;
    if constexpr (Epi::AFTER_DRAIN) { E.fused(acc, cur, wr, wc, fr, fq, lds, wid, lane); S.done(cur); }
    PG8_STAMP();
    if (STAMP && wid == 0) { stamps[lane] = lane < nts ? (((unsigned long long)(unsigned)ts_hi << 32) | (unsigned)ts_lo) : 0ull;
        if (lane == 62) stamps[62] = rt_entry; if (lane == 63) stamps[63] = (unsigned long long)wall_clock64(); }
#undef PG8_STAMP
#undef PG8_SA
#undef PG8_SB
#undef PG8_STAGE
#undef PG8_LDA
#undef PG8_LDB
#undef PG8_MMA
#undef PG8_WAIT_V
#undef PG8_WAIT_L
#undef PG8_BAR
#undef PG8_SCHED
}
}

using pg8::bf16_t; using pg8::bf16x8; using pg8::f32x4; using pg8::u32x4;
typedef float f32x16 __attribute__((ext_vector_type(16)));
typedef float f32x2v __attribute__((ext_vector_type(2)));
typedef unsigned u32x2 __attribute__((ext_vector_type(2)));
typedef __bf16 bf16v2 __attribute__((ext_vector_type(2)));
#ifndef SKIP_P0
#define SKIP_P0 0
#endif
#ifndef SKIP_P1
#define SKIP_P1 0
#endif
#ifndef SKIP_P2
#define SKIP_P2 0
#endif
#ifndef SKIP_P3
#define SKIP_P3 0
#endif
#ifndef SKIP_P4
#define SKIP_P4 0
#endif
#ifndef SKIP_P5
#define SKIP_P5 0
#endif
#ifndef SKIP_P6
#define SKIP_P6 0
#endif
#ifndef SKIP_P7
#define SKIP_P7 0
#endif
#ifndef SKIP_P8
#define SKIP_P8 0
#endif
#ifndef SKIP_P9
#define SKIP_P9 0
#endif
#ifndef REP_P0
#define REP_P0 1
#endif
#ifndef REP_P1
#define REP_P1 1
#endif
#ifndef REP_P2
#define REP_P2 1
#endif
#ifndef REP_P3
#define REP_P3 1
#endif
#ifndef REP_P4
#define REP_P4 1
#endif
#ifndef REP_P5
#define REP_P5 1
#endif
#ifndef REP_P6
#define REP_P6 1
#endif
#ifndef REP_P7
#define REP_P7 1
#endif
#ifndef REP_P8
#define REP_P8 1
#endif
#ifndef REP_P9
#define REP_P9 1
#endif
#define LAS __attribute__((address_space(3)))
#define DI __device__ __forceinline__

constexpr int T_ = 32768, D_ = 2048, S_ = 8192, DFF_ = 5632, DIN_ = 10256, PLD = 4096;
constexpr size_t MIB = (size_t)1 << 20;
constexpr size_t WS_W1T = 0, WS_W2T = 32 * MIB, WS_WBM = 42 * MIB, WS_WBA = 46 * MIB, WS_WOUT = 50 * MIB, WS_WFFI = 58 * MIB, WS_WFFO = 102 * MIB;
constexpr size_t WS_RA = 128 * MIB, WS_PROJ = 256 * MIB, WS_GT = 512 * MIB, WS_X2 = 608 * MIB, WS_XT = 768 * MIB, WS_SMALL = 928 * MIB;
constexpr size_t WS_G16 = WS_SMALL, WS_BC = WS_SMALL + 2 * MIB, WS_U = WS_SMALL + 3 * MIB, WS_PM = WS_SMALL + 4 * MIB, WS_COS = WS_SMALL + 5 * MIB, WS_SIN = WS_SMALL + 6 * MIB, WS_MISC = WS_SMALL + 7 * MIB, WS_BAR = WS_SMALL + 7 * MIB + 65536;
constexpr int LDS_STAGE = 131072, LDS_BYTES = LDS_STAGE + 1024;
constexpr float EPS_ = 1e-6f;
constexpr float KSCALE = 0.08838834764831845f;
constexpr float QSCALE = 0.125f * 1.4426950408889634f;
constexpr int N_MLSTM_ITEMS = 128, N_ATTN_ITEMS = 2048;

struct Params { const float* in[19]; float* out; unsigned char* ws; };
__device__ __forceinline__ unsigned long long karg64(int off) { unsigned long long r; asm volatile("s_load_dwordx2 %0, %1, %2\n\ts_waitcnt lgkmcnt(0)" : "=s"(r) : "s"(__builtin_amdgcn_kernarg_segment_ptr()), "n"(off)); return r; }
__device__ __forceinline__ unsigned long long karg64d(int off) { unsigned long long r; asm volatile("s_load_dwordx2 %0, %1, %2\n\ts_waitcnt lgkmcnt(0)" : "=s"(r) : "s"(__builtin_amdgcn_kernarg_segment_ptr()), "s"(__builtin_amdgcn_readfirstlane(off))); return r; }
#define GAS __attribute__((address_space(1)))
#define KIN(i) ((const float*)(const GAS float*)karg64(8 * (i)))
#define KOUT ((float*)(GAS float*)karg64(152))
#define KWS ((unsigned char*)(GAS unsigned char*)karg64(160))

__constant__ float c_inv[32] = {1.000000000e+00f, 7.498942614e-01f, 5.623413324e-01f, 4.216965139e-01f, 3.162277639e-01f, 2.371373773e-01f, 1.778279394e-01f, 1.333521307e-01f, 1.000000015e-01f, 7.498941571e-02f, 5.623413250e-02f, 4.216965288e-02f, 3.162277490e-02f, 2.371373773e-02f, 1.778279431e-02f, 1.333521493e-02f, 9.999999776e-03f, 7.498941850e-03f, 5.623413250e-03f, 4.216964822e-03f, 3.162277630e-03f, 2.371373586e-03f, 1.778279431e-03f, 1.333521446e-03f, 1.000000047e-03f, 7.498942432e-04f, 5.623413017e-04f, 4.216965172e-04f, 3.162277571e-04f, 2.371373703e-04f, 1.778279402e-04f, 1.333521504e-04f};

struct ConvReg { int src, ld, K, ngroups, kind, col0; unsigned long long dst; float scale; int pad; };
constexpr int NREG = 13;
__constant__ ConvReg c_regs[NREG] = {
    {2, DIN_, 2048, 8, 0, 0, WS_W1T, 1.0f, 0},
    {2, DIN_, 2048, 8, 0, 512, WS_W1T + 512ull * 4096, KSCALE, 0},
    {2, DIN_, 2048, 16, 0, 2048, WS_W1T + 1024ull * 4096, 1.0f, 0},
    {2, DIN_, 2048, 16, 1, 3088, WS_W1T + 2048ull * 4096, QSCALE, 0},
    {2, DIN_, 2048, 16, 1, 4112, WS_W1T + 3072ull * 4096, 1.0f, 0},
    {2, DIN_, 2048, 64, 0, 6160, WS_W1T + 4096ull * 4096, 1.0f, 0},
    {2, DIN_, 2048, 16, 0, 1024, WS_W2T, 1.0f, 0},
    {2, DIN_, 2048, 16, 0, 5136, WS_W2T + 1024ull * 4096, 1.0f, 0},
    {12, 2048, 1024, 32, 0, 0, WS_WBM, 1.0f, 0},
    {13, 2048, 1024, 32, 0, 0, WS_WBA, 1.0f, 0},
    {14, 2048, 2048, 32, 0, 0, WS_WOUT, 1.0f, 0},
    {16, 2 * DFF_, 2048, 176, 2, 0, WS_WFFI, 1.0f, 0},
    {17, 2048, DFF_, 32, 0, 0, WS_WFFO, 1.0f, 0}};

DI unsigned short f2bf(float f) { unsigned u = __float_as_uint(f); u += 0x7fffu + ((u >> 16) & 1u); return (unsigned short)(u >> 16); }
DI float bf2f(unsigned short b) { return __uint_as_float(((unsigned)b) << 16); }
DI float bflo(unsigned w) { return __uint_as_float(w << 16); }
DI float bfhi(unsigned w) { return __uint_as_float(w & 0xffff0000u); }
DI unsigned pk2(float lo, float hi) { f32x2v v = {lo, hi}; bf16v2 r = __builtin_convertvector(v, bf16v2); return __builtin_bit_cast(unsigned, r); }
DI bf16x8 pack8(float a0, float a1, float a2, float a3, float a4, float a5, float a6, float a7) { u32x4 p; p.x = pk2(a0, a1); p.y = pk2(a2, a3); p.z = pk2(a4, a5); p.w = pk2(a6, a7); return __builtin_bit_cast(bf16x8, p); }
DI float sigmoidf_(float x) { return __builtin_amdgcn_rcpf(1.0f + __expf(-x)); }
DI float wave_sum(float v) { for (int o = 32; o >= 1; o >>= 1) v += __shfl_xor(v, o); return v; }
DI int fresh_tid() { int t = threadIdx.x; asm volatile("" : "+v"(t)); return t; }
#define MFMA16(a, b, c) __builtin_amdgcn_mfma_f32_16x16x32_bf16((a), (b), (c), 0, 0, 0)
#define MFMA32(a, b, c) __builtin_amdgcn_mfma_f32_32x32x16_bf16((a), (b), (c), 0, 0, 0)

struct ConvU { const float* src; bf16_t* dst; int ld, K, kind; float scale; };
DI ConvU conv_decode(int u, int tid) {
    int ri = 0, lu = u;
    for (; ri < NREG - 1; ++ri) { const int n = c_regs[ri].ngroups * (c_regs[ri].K >> 6); if (lu < n) break; lu -= n; }
    ConvU U; U.ld = c_regs[ri].ld; U.K = c_regs[ri].K; U.kind = c_regs[ri].kind; U.scale = c_regs[ri].scale;
    const int nK = U.K >> 6, g = lu / nK, kt = lu - g * nK;
    int cbase;
    if (U.kind == 2) { const int pn = g >> 2, q = g & 3; cbase = (q < 2) ? (128 * pn + 64 * q) : (DFF_ + 128 * pn + 64 * (q - 2)); }
    else cbase = c_regs[ri].col0 + 64 * g;
    U.src = ((const float*)(const GAS float*)karg64d(8 * c_regs[ri].src)) + (size_t)(64 * kt) * U.ld + cbase + (size_t)(tid >> 6) * U.ld + (tid & 63);
    U.dst = (bf16_t*)(KWS + c_regs[ri].dst) + (size_t)(64 * g + (tid >> 3)) * U.K + 64 * kt + (tid & 7) * 8;
    return U;
}
DI void conv_units(int u0, int u1, int stride, LAS float* tile, int tid) {
    if (u0 >= u1) return;
    ConvU U = conv_decode(u0, tid);
    float v[8];
#pragma unroll
    for (int i = 0; i < 8; ++i) v[i] = U.src[(size_t)(8 * i) * U.ld];
    for (int u = u0; u < u1; u += stride) {
        const bool more = u + stride < u1;
        ConvU N = U; float nv[8];
        if (more) { N = conv_decode(u + stride, tid);
#pragma unroll
            for (int i = 0; i < 8; ++i) nv[i] = N.src[(size_t)(8 * i) * N.ld]; }
        { const int col = tid & 63, kr0 = tid >> 6;
#pragma unroll
          for (int i = 0; i < 8; ++i) tile[(kr0 + 8 * i) * 65 + col] = v[i] * U.scale; }
        __syncthreads();
        { const int rr = tid >> 3, ks = (tid & 7) * 8;
          const int sc = (U.kind == 1) ? ((rr & 1) ? (rr >> 1) + 32 : (rr >> 1)) : rr;
          float w[8];
#pragma unroll
          for (int j = 0; j < 8; ++j) w[j] = tile[(ks + j) * 65 + sc];
          *(bf16x8*)U.dst = pack8(w[0], w[1], w[2], w[3], w[4], w[5], w[6], w[7]); }
        __syncthreads();
        if (more) { U = N;
#pragma unroll
            for (int i = 0; i < 8; ++i) v[i] = nv[i]; }
    }
}

DI void p0_norm_gates(LAS float* Wg, int tid) {
    const float* x = KIN(0); const float* n1 = KIN(1); const float* w_in = KIN(2);
    for (int e = tid; e < 16 * 2048; e += 512) { const int k = e >> 4, j = e & 15; Wg[j * 2048 + k] = w_in[(size_t)k * DIN_ + 3072 + j] * n1[k]; }
    __syncthreads();
    const int lane = tid & 63, w = tid >> 6;
    unsigned char* const wsp = KWS; bf16_t* H = (bf16_t*)(wsp + WS_RA); float* G16 = (float*)(wsp + WS_G16);
    const int nw = gridDim.x * 8;
    for (int pr = blockIdx.x * 8 + w; pr < T_ / 2; pr += nw) {
        const float* xa = x + (size_t)(2 * pr) * D_; const float* xb = xa + D_;
        float sa = 0.f, sb = 0.f;
        float ga[16], gb[16];
#pragma unroll
        for (int j = 0; j < 16; ++j) { ga[j] = 0.f; gb[j] = 0.f; }
#pragma unroll 1
        for (int i = 0; i < 8; ++i) {
            const f32x4 va = *(const f32x4*)(xa + 4 * lane + 256 * i), vb = *(const f32x4*)(xb + 4 * lane + 256 * i);
            sa += va[0] * va[0] + va[1] * va[1] + va[2] * va[2] + va[3] * va[3]; sb += vb[0] * vb[0] + vb[1] * vb[1] + vb[2] * vb[2] + vb[3] * vb[3];
#pragma unroll
            for (int j = 0; j < 16; ++j) { const f32x4 wv = *(const LAS f32x4*)(Wg + j * 2048 + 4 * lane + 256 * i);
                ga[j] += va[0] * wv[0] + va[1] * wv[1] + va[2] * wv[2] + va[3] * wv[3];
                gb[j] += vb[0] * wv[0] + vb[1] * wv[1] + vb[2] * wv[2] + vb[3] * wv[3]; }
        }
        sa = wave_sum(sa); sb = wave_sum(sb);
        const float ra = rsqrtf(sa * (1.0f / D_) + EPS_), rb = rsqrtf(sb * (1.0f / D_) + EPS_);
        float oa = 0.f, ob = 0.f;
#pragma unroll
        for (int j = 0; j < 16; ++j) { const float ta = wave_sum(ga[j]), tb = wave_sum(gb[j]); if (lane == j) { oa = ta; ob = tb; } }
        if (lane < 16) { G16[(size_t)(2 * pr) * 16 + lane] = oa * ra; G16[(size_t)(2 * pr + 1) * 16 + lane] = ob * rb; }
#pragma unroll 2
        for (int i = 0; i < 8; ++i) { const f32x4 nw4 = *(const f32x4*)(n1 + 4 * lane + 256 * i);
            const f32x4 va = *(const f32x4*)(xa + 4 * lane + 256 * i), vb = *(const f32x4*)(xb + 4 * lane + 256 * i);
            u32x2 oa2, ob2;
            oa2.x = pk2(va[0] * ra * nw4[0], va[1] * ra * nw4[1]); oa2.y = pk2(va[2] * ra * nw4[2], va[3] * ra * nw4[3]);
            ob2.x = pk2(vb[0] * rb * nw4[0], vb[1] * rb * nw4[1]); ob2.y = pk2(vb[2] * rb * nw4[2], vb[3] * rb * nw4[3]);
            *(u32x2*)(H + (size_t)(2 * pr) * D_ + 4 * lane + 256 * i) = oa2; *(u32x2*)(H + (size_t)(2 * pr + 1) * D_ + 4 * lane + 256 * i) = ob2; }
    }
}

template <bool TO_BF16>
DI void rows_rmsnorm(const float* X, const float* wgt, bf16_t* Ob, float* Of, int tid) {
    const int lane = tid & 63, w = tid >> 6; const int nw = gridDim.x * 8;
    for (int t = blockIdx.x * 8 + w; t < T_; t += nw) {
        const float* xr = X + (size_t)t * D_;
        f32x4 v[8]; float s = 0.f;
#pragma unroll
        for (int i = 0; i < 8; ++i) { v[i] = *(const f32x4*)(xr + 4 * lane + 256 * i); s += v[i][0] * v[i][0] + v[i][1] * v[i][1] + v[i][2] * v[i][2] + v[i][3] * v[i][3]; }
        s = wave_sum(s); const float r = rsqrtf(s * (1.0f / D_) + EPS_);
#pragma unroll
        for (int i = 0; i < 8; ++i) { const f32x4 g = *(const f32x4*)(wgt + 4 * lane + 256 * i);
            if (TO_BF16) { u32x2 o; o.x = pk2(v[i][0] * r * g[0], v[i][1] * r * g[1]); o.y = pk2(v[i][2] * r * g[2], v[i][3] * r * g[3]); *(u32x2*)(Ob + (size_t)t * D_ + 4 * lane + 256 * i) = o; }
            else { f32x4 o; o[0] = v[i][0] * r * g[0]; o[1] = v[i][1] * r * g[1]; o[2] = v[i][2] * r * g[2]; o[3] = v[i][3] * r * g[3]; *(f32x4*)(Of + (size_t)t * D_ + 4 * lane + 256 * i) = o; }
        }
    }
}

template <bool TO_BF16>
DI void rows_rmsnorm_bf(const bf16_t* X, const float* wgt, bf16_t* Ob, float* Of, int tid) {
    const int lane = tid & 63, w = tid >> 6; const int nw = gridDim.x * 8;
    for (int tp = blockIdx.x * 8 + w; tp < T_ / 2; tp += nw) {
        u32x4 v[2][4]; float s[2] = {0.f, 0.f};
#pragma unroll
        for (int h = 0; h < 2; ++h) { const bf16_t* xr = X + (size_t)(2 * tp + h) * D_;
#pragma unroll
            for (int i = 0; i < 4; ++i) v[h][i] = *(const u32x4*)(xr + 8 * lane + 512 * i); }
#pragma unroll
        for (int h = 0; h < 2; ++h)
#pragma unroll
            for (int i = 0; i < 4; ++i) { const u32x4 q = v[h][i];
                s[h] += bflo(q.x) * bflo(q.x) + bfhi(q.x) * bfhi(q.x) + bflo(q.y) * bflo(q.y) + bfhi(q.y) * bfhi(q.y) + bflo(q.z) * bflo(q.z) + bfhi(q.z) * bfhi(q.z) + bflo(q.w) * bflo(q.w) + bfhi(q.w) * bfhi(q.w); }
        s[0] = wave_sum(s[0]); s[1] = wave_sum(s[1]);
#pragma unroll
        for (int i = 0; i < 4; ++i) { const f32x4 g0 = *(const f32x4*)(wgt + 8 * lane + 512 * i), g1 = *(const f32x4*)(wgt + 8 * lane + 512 * i + 4);
#pragma unroll
            for (int h = 0; h < 2; ++h) { const float r = rsqrtf(s[h] * (1.0f / D_) + EPS_); const u32x4 q = v[h][i]; const size_t o_ = (size_t)(2 * tp + h) * D_ + 8 * lane + 512 * i;
                const float o0 = bflo(q.x) * r * g0[0], o1 = bfhi(q.x) * r * g0[1], o2 = bflo(q.y) * r * g0[2], o3 = bfhi(q.y) * r * g0[3];
                const float o4 = bflo(q.z) * r * g1[0], o5 = bfhi(q.z) * r * g1[1], o6 = bflo(q.w) * r * g1[2], o7 = bfhi(q.w) * r * g1[3];
                if (TO_BF16) { u32x4 o; o.x = pk2(o0, o1); o.y = pk2(o2, o3); o.z = pk2(o4, o5); o.w = pk2(o6, o7); *(u32x4*)(Ob + o_) = o; }
                else { *(f32x4*)(Of + o_) = (f32x4){o0, o1, o2, o3}; *(f32x4*)(Of + o_ + 4) = (f32x4){o4, o5, o6, o7}; } } }
    }
}

struct EpiMain {
    static constexpr bool PERM = true, AFTER_DRAIN = false, CHAIN = false;
    bf16_t* O; bf16_t* GT; const float* gbias; const float* cosT; const float* sinT;
    DI void operator()(const f32x4 (&acc)[2][2][4][2], const pg8::Unit& u, int wr, int wc, int fr, int fq) const {
        const int row0 = u.pm * 256 + wr * 64 + fr, colb = u.pn * 256 + wc * 32 + 8 * fq;
        const int ty = (u.pn < 4) ? 0 : (u.pn < 8) ? 1 : (u.pn < 16) ? 2 : 3;
#pragma unroll
        for (int ai = 0; ai < 2; ++ai)
#pragma unroll
            for (int m = 0; m < 4; ++m) {
                const int row = row0 + ai * 128 + m * 16; bf16_t* rowp = O + (size_t)row * PLD + colb;
                f32x4 cs = {1.f, 1.f, 1.f, 1.f}, sn = {0.f, 0.f, 0.f, 0.f};
                if (ty == 2) { const int pos = row & (S_ - 1), j0 = 16 * (wc & 1) + 4 * fq; cs = *(const f32x4*)(cosT + pos * 32 + j0); sn = *(const f32x4*)(sinT + pos * 32 + j0); }
                u32x4 gq = {0u, 0u, 0u, 0u};
#pragma unroll
                for (int bj = 0; bj < 2; ++bj) {
                    f32x4 v0 = acc[ai][bj][m][0], v1 = acc[ai][bj][m][1];
                    if (ty == 1) {
#pragma unroll
                        for (int j = 0; j < 4; ++j) { v0[j] = sigmoidf_(v0[j]); v1[j] = sigmoidf_(v1[j]); }
                    } else if (ty == 2) {
                        f32x4 a, b;
                        a[0] = v0[0] * cs[0] - v0[1] * sn[0]; a[1] = v0[0] * sn[0] + v0[1] * cs[0];
                        a[2] = v0[2] * cs[1] - v0[3] * sn[1]; a[3] = v0[2] * sn[1] + v0[3] * cs[1];
                        b[0] = v1[0] * cs[2] - v1[1] * sn[2]; b[1] = v1[0] * sn[2] + v1[1] * cs[2];
                        b[2] = v1[2] * cs[3] - v1[3] * sn[3]; b[3] = v1[2] * sn[3] + v1[3] * cs[3];
                        v0 = a; v1 = b;
                    } else if (ty == 3) {
                        const float* bp = gbias + (colb + bj * 128 - 4096);
                        const f32x4 b0 = *(const f32x4*)bp, b1 = *(const f32x4*)(bp + 4);
#pragma unroll
                        for (int j = 0; j < 4; ++j) { v0[j] = sigmoidf_(v0[j] + b0[j]); v1[j] = sigmoidf_(v1[j] + b1[j]); }
                        const unsigned w0 = __float2uint_rn(v0[0] * 255.f) | (__float2uint_rn(v0[1] * 255.f) << 8) | (__float2uint_rn(v0[2] * 255.f) << 16) | (__float2uint_rn(v0[3] * 255.f) << 24);
                        const unsigned w1 = __float2uint_rn(v1[0] * 255.f) | (__float2uint_rn(v1[1] * 255.f) << 8) | (__float2uint_rn(v1[2] * 255.f) << 16) | (__float2uint_rn(v1[3] * 255.f) << 24);
                        if (bj == 0) { gq.x = w0; gq.y = w1; } else { gq.z = w0; gq.w = w1; }
                    }
                    if (ty != 3) { u32x4 o; o.x = pk2(v0[0], v0[1]); o.y = pk2(v0[2], v0[3]); o.z = pk2(v1[0], v1[1]); o.w = pk2(v1[2], v1[3]);
                        __builtin_nontemporal_store(o, (u32x4*)(rowp + bj * 128)); }
                }
                if (ty == 3) __builtin_nontemporal_store(gq, (u32x4*)((unsigned char*)GT + ((size_t)(u.pm * 16 + (u.pn - 16)) * 8 + (ai * 4 + m)) * 8192 + (size_t)(((wr * 4 + wc) * 4 + fq) * 16 + fr) * 16));
            }
    }
};
struct EpiPlain {
    static constexpr bool PERM = true, AFTER_DRAIN = false, CHAIN = false;
    bf16_t* O; int ldc;
    DI void operator()(const f32x4 (&acc)[2][2][4][2], const pg8::Unit& u, int wr, int wc, int fr, int fq) const {
        const int row0 = u.pm * 256 + wr * 64 + fr, colb = u.pn * 256 + wc * 32 + 8 * fq;
#pragma unroll
        for (int ai = 0; ai < 2; ++ai)
#pragma unroll
            for (int m = 0; m < 4; ++m) { bf16_t* rowp = O + (size_t)(row0 + ai * 128 + m * 16) * ldc + colb;
#pragma unroll
                for (int bj = 0; bj < 2; ++bj) { const f32x4 v0 = acc[ai][bj][m][0], v1 = acc[ai][bj][m][1];
                    u32x4 o; o.x = pk2(v0[0], v0[1]); o.y = pk2(v0[2], v0[3]); o.z = pk2(v1[0], v1[1]); o.w = pk2(v1[2], v1[3]);
                    __builtin_nontemporal_store(o, (u32x4*)(rowp + bj * 128)); } }
    }
};
struct BranchOrder : pg8::StaticOrder {
    __device__ bool next(int i, pg8::Unit& u) const { if (!pg8::StaticOrder::next(i >> 1, u)) return false; if (i & 1) { u.pm += T_ / 256; u.pn += 2048 / 256; } return true; }
};
struct EpiBranchChain {
    static constexpr bool PERM = true, AFTER_DRAIN = false, CHAIN = true;
    const bf16_t* gt; bf16_t* mg;
    DI bool chain(f32x4 (&acc)[2][2][4][2], const pg8::Unit& u, int wr, int wc, int fr, int fq) const {
        const bool second = u.pm >= T_ / 256;
        const int pm = second ? u.pm - T_ / 256 : u.pm, pn = second ? u.pn - 2048 / 256 : u.pn;
        const int row0 = pm * 256 + wr * 64 + fr, colb = pn * 256 + wc * 32 + 8 * fq;
#pragma unroll
        for (int ai = 0; ai < 2; ++ai)
#pragma unroll
            for (int m = 0; m < 4; ++m) { const int row = row0 + ai * 128 + m * 16;
#pragma unroll
                for (int bj = 0; bj < 2; ++bj) { const int col = colb + bj * 128;
                    const size_t gsl = (size_t)(ai * 4 + m) * 8192 + (size_t)(((wr * 4 + wc) * 4 + fq) * 16 + fr) * 16 + bj * 8;
                    const u32x2 gar = *(const u32x2*)((const unsigned char*)gt + (size_t)(pm * 16 + pn + 8) * 65536 + gsl);
                    const float k255 = 1.0f / 255.0f;
                    const float a0 = fmaxf((float)(gar.x & 255u) * k255, 1e-30f), a1 = fmaxf((float)((gar.x >> 8) & 255u) * k255, 1e-30f), a2 = fmaxf((float)((gar.x >> 16) & 255u) * k255, 1e-30f), a3 = fmaxf((float)(gar.x >> 24) * k255, 1e-30f);
                    const float a4 = fmaxf((float)(gar.y & 255u) * k255, 1e-30f), a5 = fmaxf((float)((gar.y >> 8) & 255u) * k255, 1e-30f), a6 = fmaxf((float)((gar.y >> 16) & 255u) * k255, 1e-30f), a7 = fmaxf((float)(gar.y >> 24) * k255, 1e-30f);
                    f32x4& v0 = acc[ai][bj][m][0]; f32x4& v1 = acc[ai][bj][m][1];
                    if (!second) {
                        const u32x2 gm = *(const u32x2*)((const unsigned char*)gt + (size_t)(pm * 16 + pn) * 65536 + gsl);
                        v0[0] *= (float)(gm.x & 255u) * k255 * __builtin_amdgcn_rcpf(a0); v0[1] *= (float)((gm.x >> 8) & 255u) * k255 * __builtin_amdgcn_rcpf(a1);
                        v0[2] *= (float)((gm.x >> 16) & 255u) * k255 * __builtin_amdgcn_rcpf(a2); v0[3] *= (float)(gm.x >> 24) * k255 * __builtin_amdgcn_rcpf(a3);
                        v1[0] *= (float)(gm.y & 255u) * k255 * __builtin_amdgcn_rcpf(a4); v1[1] *= (float)((gm.y >> 8) & 255u) * k255 * __builtin_amdgcn_rcpf(a5);
                        v1[2] *= (float)((gm.y >> 16) & 255u) * k255 * __builtin_amdgcn_rcpf(a6); v1[3] *= (float)(gm.y >> 24) * k255 * __builtin_amdgcn_rcpf(a7);
                    } else {
                        u32x4 o; o.x = pk2(v0[0] * a0, v0[1] * a1); o.y = pk2(v0[2] * a2, v0[3] * a3);
                        o.z = pk2(v1[0] * a4, v1[1] * a5); o.w = pk2(v1[2] * a6, v1[3] * a7);
                        *(u32x4*)(mg + (size_t)row * D_ + col) = o;
                    } } }
        return !second;
    }
};
struct EpiResid {
    static constexpr bool PERM = false, AFTER_DRAIN = false, CHAIN = false;
    const float* base; float* out;
    DI void operator()(const f32x4 (&acc)[2][2][4][2], const pg8::Unit& u, int wr, int wc, int fr, int fq) const {
        const int row0 = u.pm * 256 + wr * 64 + fr, col0 = u.pn * 256 + wc * 32 + 4 * fq;
#pragma unroll
        for (int ai = 0; ai < 2; ++ai)
#pragma unroll
            for (int m = 0; m < 4; ++m) { const size_t off = (size_t)(row0 + ai * 128 + m * 16) * D_ + col0;
#pragma unroll
                for (int bj = 0; bj < 2; ++bj)
#pragma unroll
                    for (int n = 0; n < 2; ++n) { const f32x4 b = *(const f32x4*)(base + off + bj * 128 + n * 16); *(f32x4*)(out + off + bj * 128 + n * 16) = b + acc[ai][bj][m][n]; } }
    }
};
struct EpiResidBf {
    static constexpr bool PERM = true, AFTER_DRAIN = false, CHAIN = false;
    const float* base; bf16_t* out;
    DI void operator()(const f32x4 (&acc)[2][2][4][2], const pg8::Unit& u, int wr, int wc, int fr, int fq) const {
        const int row0 = u.pm * 256 + wr * 64 + fr, col0 = u.pn * 256 + wc * 32 + 8 * fq;
#pragma unroll
        for (int ai = 0; ai < 2; ++ai)
#pragma unroll
            for (int m = 0; m < 4; ++m) { const size_t off = (size_t)(row0 + ai * 128 + m * 16) * D_ + col0;
#pragma unroll
                for (int bj = 0; bj < 2; ++bj) { const f32x4 b0 = *(const f32x4*)(base + off + bj * 128), b1 = *(const f32x4*)(base + off + bj * 128 + 4);
                    const f32x4 v0 = b0 + acc[ai][bj][m][0], v1 = b1 + acc[ai][bj][m][1];
                    u32x4 o; o.x = pk2(v0[0], v0[1]); o.y = pk2(v0[2], v0[3]); o.z = pk2(v1[0], v1[1]); o.w = pk2(v1[2], v1[3]);
                    *(u32x4*)(out + off + bj * 128) = o; } }
    }
};
struct EpiResidBfBf {
    static constexpr bool PERM = true, AFTER_DRAIN = false, CHAIN = false;
    const bf16_t* base; bf16_t* out;
    DI void operator()(const f32x4 (&acc)[2][2][4][2], const pg8::Unit& u, int wr, int wc, int fr, int fq) const {
        const int row0 = u.pm * 256 + wr * 64 + fr, col0 = u.pn * 256 + wc * 32 + 8 * fq;
#pragma unroll
        for (int ai = 0; ai < 2; ++ai)
#pragma unroll
            for (int m = 0; m < 4; ++m) { const size_t off = (size_t)(row0 + ai * 128 + m * 16) * D_ + col0;
#pragma unroll
                for (int bj = 0; bj < 2; ++bj) { const u32x4 b = *(const u32x4*)(base + off + bj * 128);
                    const f32x4 v0 = acc[ai][bj][m][0], v1 = acc[ai][bj][m][1];
                    u32x4 o; o.x = pk2(v0[0] + bflo(b.x), v0[1] + bfhi(b.x)); o.y = pk2(v0[2] + bflo(b.y), v0[3] + bfhi(b.y)); o.z = pk2(v1[0] + bflo(b.z), v1[1] + bfhi(b.z)); o.w = pk2(v1[2] + bflo(b.w), v1[3] + bfhi(b.w));
                    *(u32x4*)(out + off + bj * 128) = o; } }
    }
};
struct EpiSwiglu {
    static constexpr bool PERM = true, AFTER_DRAIN = false, CHAIN = false;
    bf16_t* act;
    DI void operator()(const f32x4 (&acc)[2][2][4][2], const pg8::Unit& u, int wr, int wc, int fr, int fq) const {
        const int row0 = u.pm * 256 + wr * 64 + fr, col = u.pn * 128 + wc * 32 + 8 * fq;
#pragma unroll
        for (int ai = 0; ai < 2; ++ai)
#pragma unroll
            for (int m = 0; m < 4; ++m) { const int row = row0 + ai * 128 + m * 16;
                float r[8];
#pragma unroll
                for (int n = 0; n < 2; ++n)
#pragma unroll
                    for (int j = 0; j < 4; ++j) { const float g = acc[ai][0][m][n][j], up = acc[ai][1][m][n][j]; r[4 * n + j] = g * sigmoidf_(g) * up; }
                u32x4 o; o.x = pk2(r[0], r[1]); o.y = pk2(r[2], r[3]); o.z = pk2(r[4], r[5]); o.w = pk2(r[6], r[7]);
                __builtin_nontemporal_store(o, (u32x4*)(act + (size_t)row * DFF_ + col)); }
    }
};

DI void gate_prep(int tid) {
    const int lane = tid & 63, w = tid >> 6; const int nw = gridDim.x * 8;
    unsigned char* const wsp = KWS; const float* bigate = KIN(3); const float* bfgate = KIN(4);
    const float* G16 = (const float*)(wsp + WS_G16);
    float* BC = (float*)(wsp + WS_BC); float* U = (float*)(wsp + WS_U); float* PM = (float*)(wsp + WS_PM);
    for (int id = blockIdx.x * 8 + w; id < 32 * 64; id += nw) {
        const int stream = id >> 6, pc = id & 63; const int dir = stream >> 4, b = (stream >> 2) & 3, h = stream & 3;
        const float bi = bigate[dir * 4 + h], bfg = bfgate[dir * 4 + h];
        float lf[2], ig[2];
#pragma unroll
        for (int e = 0; e < 2; ++e) { const int i = 2 * lane + e; const int p = dir ? 127 - i : i; const size_t tok = (size_t)b * S_ + pc * 128 + p;
            const float gi = G16[tok * 16 + dir * 8 + h] + bi, gf = G16[tok * 16 + dir * 8 + 4 + h] + bfg;
            ig[e] = 15.0f * tanhf(gi * (1.0f / 15.0f));
            const float fc = 15.0f * tanhf(gf * (1.0f / 15.0f));
            lf[e] = fminf(fc, 0.f) - log1pf(expf(-fabsf(fc))); }
        float s = lf[0] + lf[1];
#pragma unroll
        for (int o = 1; o < 64; o <<= 1) { const float t = __shfl_up(s, o); if (lane >= o) s += t; }
        const float b1 = s, b0 = s - lf[1];
        const float u0 = ig[0] - b0, u1 = ig[1] - b1;
        float mx = fmaxf(u0, u1);
#pragma unroll
        for (int o = 1; o < 64; o <<= 1) { const float t = __shfl_up(mx, o); if (lane >= o) mx = fmaxf(mx, t); }
        float mprev = __shfl_up(mx, 1); if (lane == 0) mprev = -INFINITY;
        const float pm0 = fmaxf(mprev, u0), pm1 = mx;
        const size_t base = (size_t)stream * S_ + pc * 128;
        const int p0 = dir ? 127 - 2 * lane : 2 * lane, p1 = dir ? 126 - 2 * lane : 2 * lane + 1;
        BC[base + p0] = b0; BC[base + p1] = b1; U[base + p0] = u0; U[base + p1] = u1; PM[base + p0] = pm0; PM[base + p1] = pm1;
    }
}

DI void mlstm_item(int item, LAS unsigned char* lds, int tid_in) {
    int tid = tid_in; asm volatile("" : "+v"(tid));
    const int lane = tid & 63, w = tid >> 6, fr = lane & 15, fq = lane >> 4;
    const int vs = item & 3, h = (item >> 2) & 3, b = (item >> 4) & 3, dir = item >> 6;
    const int stream = dir * 16 + b * 4 + h;
    constexpr int LD = 136;
    LAS bf16_t* Ks = (LAS bf16_t*)lds; LAS bf16_t* KTs = Ks + 128 * LD; LAS bf16_t* VTs = KTs + 128 * LD; LAS bf16_t* VTw = VTs + 64 * LD; LAS bf16_t* Cs = VTw + 64 * LD;
    LAS float* su = (LAS float*)(Cs + 64 * LD); LAS float* spm = su + 128; LAS float* sbc = su + 256; LAS float* swk = su + 384; LAS float* snl = su + 512; LAS float* sunx = su + 640; LAS float* spart = su + 768;
    for (int e = tid; e < 64 * LD / 2; e += 512) ((LAS unsigned*)Cs)[e] = 0u;
    if (tid < 128) snl[tid] = 0.f;
    f32x4 Cacc[4];
#pragma unroll
    for (int i = 0; i < 4; ++i) Cacc[i] = (f32x4){0.f, 0.f, 0.f, 0.f};
    float nreg = 0.f, mcar = 0.f;
    unsigned char* const wsp = KWS;
    const bf16_t* proj = (const bf16_t*)(wsp + WS_PROJ); const bf16_t* xt = (const bf16_t*)(wsp + WS_XT);
    const bf16_t* Qg = proj + h * 128; const bf16_t* Kg = proj + 512 + h * 128;
    const bf16_t* VTg = xt + (size_t)(h * 256 + vs * 64) * T_;
    bf16_t* HX = (bf16_t*)KOUT + (dir ? (size_t)T_ * 1024 : 0) + h * 256 + vs * 64;
    const float* Ug = (const float*)(wsp + WS_U) + (size_t)stream * S_; const float* PMg = (const float*)(wsp + WS_PM) + (size_t)stream * S_; const float* BCg = (const float*)(wsp + WS_BC) + (size_t)stream * S_;
    const int plast = dir ? 0 : 127;
    bf16x8 kreg[4], vtreg[2], Bq[4]; float myu = 0.f, mypm = 0.f, mybc = 0.f, pm_end_n, bL_n;
#define ML_LOAD(CN) do { const int pc_ = dir ? 63 - (CN) : (CN); const int p0_ = pc_ * 128; const size_t tk_ = (size_t)b * S_ + p0_; int tv_ = tid; asm volatile("" : "+v"(tv_)); \
        _Pragma("unroll") for (int i = 0; i < 4; ++i) { const int id = tv_ + 512 * i, r = id >> 4, sg = id & 15; \
            kreg[i] = *(const bf16x8*)(Kg + (tk_ + r) * PLD + sg * 8); } \
        _Pragma("unroll") for (int i = 0; i < 2; ++i) { const int id = tv_ + 512 * i, r = id >> 4, sg = id & 15; vtreg[i] = *(const bf16x8*)(VTg + (size_t)r * T_ + tk_ + sg * 8); } \
        _Pragma("unroll") for (int k = 0; k < 4; ++k) Bq[k] = *(const bf16x8*)(Qg + (tk_ + 16 * w + fr) * PLD + 32 * k + 8 * fq); \
        if (tv_ < 128) { myu = Ug[p0_ + tv_]; mypm = PMg[p0_ + tv_]; mybc = BCg[p0_ + tv_]; } \
        pm_end_n = PMg[p0_ + plast]; bL_n = BCg[p0_ + plast]; } while (0)
    ML_LOAD(0);
    if (tid < 128) sunx[tid] = myu;
    __syncthreads();
    for (int c = 0; c < 64; ++c) {
        const int pc = dir ? 63 - c : c; const int p0 = pc * 128; const size_t tok0 = (size_t)b * S_ + p0;
        const float pm_end = pm_end_n, bL = bL_n;
        const float Mend = fmaxf(mcar, pm_end);
        int tw = tid; asm volatile("" : "+v"(tw));
#pragma unroll
        for (int i = 0; i < 4; ++i) { const int id = tw + 512 * i, r = id >> 4, sg = id & 15; *(LAS bf16x8*)(Ks + r * LD + sg * 8) = kreg[i]; }
#pragma unroll
        for (int i = 0; i < 2; ++i) { const int id = tw + 512 * i, r = id >> 4, sg = id & 15; *(LAS bf16x8*)(VTs + r * LD + sg * 8) = vtreg[i];
            float f[8];
#pragma unroll
            for (int j = 0; j < 8; ++j) f[j] = bf2f((unsigned short)vtreg[i][j]) * __expf(sunx[sg * 8 + j] - Mend);
            *(LAS bf16x8*)(VTw + r * LD + sg * 8) = pack8(f[0], f[1], f[2], f[3], f[4], f[5], f[6], f[7]); }
        if (tid < 128) { su[tid] = myu; spm[tid] = mypm; sbc[tid] = mybc; swk[tid] = __expf(myu - Mend); }
        __syncthreads();
        const int tph = 16 * w + fr;
        int tphv = tph - 4 * fq; asm volatile("" : "+v"(tphv));
        const float Mt = fmaxf(mcar, spm[tph]);
        bf16x8 Pf[4]; float rowsum = 0.f;
#pragma unroll
        for (int kk = 0; kk < 4; ++kk) {
            float pv[8];
#pragma unroll
            for (int hh = 0; hh < 2; ++hh) { const int m = 2 * kk + hh;
                f32x4 a = {0.f, 0.f, 0.f, 0.f};
#pragma unroll
                for (int k = 0; k < 4; ++k) { const bf16x8 A = *(const LAS bf16x8*)(Ks + (16 * m + fr) * LD + 32 * k + 8 * fq); a = MFMA16(A, Bq[k], a); }
                const f32x4 us = *(const LAS f32x4*)(su + 16 * m + 4 * fq);
#pragma unroll
                for (int j = 0; j < 4; ++j) { const int sph = 16 * m + j; const bool ok = dir ? (sph >= tphv) : (sph <= tphv);
                    const float wt = ok ? __expf(us[j] - Mt) : 0.f; const float p = a[j] * wt; pv[4 * hh + j] = p; rowsum += p; }
            }
            Pf[kk] = pack8(pv[0], pv[1], pv[2], pv[3], pv[4], pv[5], pv[6], pv[7]);
        }
        rowsum += __shfl_xor(rowsum, 16); rowsum += __shfl_xor(rowsum, 32);
        f32x4 acc[4];
#pragma unroll
        for (int mv = 0; mv < 4; ++mv) { acc[mv] = (f32x4){0.f, 0.f, 0.f, 0.f};
#pragma unroll
            for (int k = 0; k < 4; ++k) { const bf16x8 A = *(const LAS bf16x8*)(Cs + (16 * mv + fr) * LD + 32 * k + 8 * fq); acc[mv] = MFMA16(A, Bq[k], acc[mv]); } }
        float qn = 0.f;
#pragma unroll
        for (int k = 0; k < 4; ++k) { const f32x4 n0 = *(const LAS f32x4*)(snl + 32 * k + 8 * fq), n1 = *(const LAS f32x4*)(snl + 32 * k + 8 * fq + 4);
#pragma unroll
            for (int j = 0; j < 4; ++j) { qn += bf2f((unsigned short)Bq[k][j]) * n0[j]; qn += bf2f((unsigned short)Bq[k][4 + j]) * n1[j]; } }
        qn += __shfl_xor(qn, 16); qn += __shfl_xor(qn, 32);
        const float at = __expf(mcar - Mt);
        const float den = at * qn + rowsum;
#pragma unroll
        for (int mv = 0; mv < 4; ++mv) acc[mv] *= at;
#pragma unroll
        for (int kk = 0; kk < 4; ++kk)
#pragma unroll
            for (int mv = 0; mv < 4; ++mv) { const LAS bf16_t* vp = VTs + (16 * mv + fr) * LD + 32 * kk + 4 * fq;
                const u32x2 lo = *(const LAS u32x2*)vp, hi = *(const LAS u32x2*)(vp + 16);
                u32x4 av; av.x = lo.x; av.y = lo.y; av.z = hi.x; av.w = hi.y;
                acc[mv] = MFMA16(__builtin_bit_cast(bf16x8, av), Pf[kk], acc[mv]); }
        {
            const float dn = fmaxf(fabsf(den), __expf(-(sbc[tph] + Mt))); const float inv = 1.0f / dn;
            bf16_t* op = HX + (tok0 + tph) * 1024 + 4 * fq;
#pragma unroll
            for (int mv = 0; mv < 4; ++mv) { u32x2 o; o.x = pk2(acc[mv][0] * inv, acc[mv][1] * inv); o.y = pk2(acc[mv][2] * inv, acc[mv][3] * inv); *(u32x2*)(op + 16 * mv) = o; }
        }
        ML_LOAD(c + 1 < 64 ? c + 1 : 63);
        const float decay = __expf(mcar - Mend);
#pragma unroll
        for (int mv = 0; mv < 4; ++mv) Cacc[mv] *= decay;
#pragma unroll
        for (int kk = 0; kk < 4; ++kk) { bf16x8 Bk;
#pragma unroll
            for (int e = 0; e < 8; ++e) Bk[e] = (short)Ks[(32 * kk + 8 * fq + e) * LD + 16 * w + fr];
#pragma unroll
            for (int mv = 0; mv < 4; ++mv) { const bf16x8 A = *(const LAS bf16x8*)(VTw + (16 * mv + fr) * LD + 32 * kk + 8 * fq); Cacc[mv] = MFMA16(A, Bk, Cacc[mv]); } }
        { float s = 0.f; const int dn = tid & 127, s0 = (tid >> 7) * 32;
#pragma unroll 8
          for (int sr = 0; sr < 32; ++sr) s += bf2f(Ks[(s0 + sr) * LD + dn]) * swk[s0 + sr];
          spart[tid] = s; }
        if (tid < 128) sunx[tid] = myu;
        __syncthreads();
#pragma unroll
        for (int mv = 0; mv < 4; ++mv)
#pragma unroll
            for (int j = 0; j < 4; ++j) Cs[(16 * mv + 4 * fq + j) * LD + 16 * w + fr] = f2bf(Cacc[mv][j]);
        if (tid < 128) { nreg = decay * nreg + ((spart[tid] + spart[128 + tid]) + (spart[256 + tid] + spart[384 + tid])); snl[tid] = nreg; }
        mcar = bL + Mend;
    }
#undef ML_LOAD
}

DI void attn_item(int item, LAS unsigned char* lds, int tid_in) {
    int tid = tid_in; asm volatile("" : "+v"(tid));
    const int lane = tid & 63, w = tid >> 6, q = lane & 31, hf = lane >> 5;
    const int qt = item & 31, hv = (item >> 5) & 15, b = item >> 9, h = hv >> 1, c = hv & 1;
    constexpr int LDK = 72, BUFE = 64 * LDK + 128 * LDK;
    LAS bf16_t* L = (LAS bf16_t*)lds;
    unsigned char* const wsp = KWS;
    const bf16_t* proj = (const bf16_t*)(wsp + WS_PROJ); const bf16_t* xt = (const bf16_t*)(wsp + WS_XT);
    const size_t tokq = (size_t)b * S_ + qt * 256 + 32 * w + q;
    const bf16_t* Qp = proj + tokq * PLD + 2048 + h * 128 + c * 64;
    bf16x8 Bq[4];
#pragma unroll
    for (int ks = 0; ks < 4; ++ks) Bq[ks] = *(const bf16x8*)(Qp + 16 * ks + 8 * hf);
    const bf16_t* Kp = proj + (size_t)b * S_ * PLD + 3072 + h * 128 + c * 64 + (size_t)(tid >> 3) * PLD + (tid & 7) * 8;
    const bf16_t* Vp0 = xt + (size_t)(1024 + h * 128 + (tid >> 3)) * T_ + (size_t)b * S_ + (tid & 7) * 8;
    const bf16_t* Vp1 = Vp0 + (size_t)64 * T_;
    const int kso = (tid >> 3) * LDK + (tid & 7) * 8, vso0 = 64 * LDK + kso, vso1 = vso0 + 64 * LDK;
    f32x16 O[4];
#pragma unroll
    for (int i = 0; i < 4; ++i)
#pragma unroll
        for (int r = 0; r < 16; ++r) O[i][r] = 0.f;
    float l = 0.f, mu = 0.f;
    f32x16 nmu;
#pragma unroll
    for (int r = 0; r < 16; ++r) nmu[r] = 0.f;
    LAS bf16_t* KB0 = L; LAS bf16_t* KB1 = L + 64 * LDK; LAS bf16_t* VB0 = L + 128 * LDK; LAS bf16_t* VB1 = VB0 + 128 * LDK;
    const int vsa = (tid >> 3) * LDK + 16 * ((tid & 7) >> 1) + 4 * (tid & 1), vsb = vsa + 64 * LDK;
#define ATT_STV(buf, r0, r1) do { const u32x4 a_ = __builtin_bit_cast(u32x4, r0), b_ = __builtin_bit_cast(u32x4, r1); \
        *(LAS u32x2*)((buf) + vsa) = (u32x2){a_.x, a_.y}; *(LAS u32x2*)((buf) + vsa + 8) = (u32x2){a_.z, a_.w}; \
        *(LAS u32x2*)((buf) + vsb) = (u32x2){b_.x, b_.y}; *(LAS u32x2*)((buf) + vsb + 8) = (u32x2){b_.z, b_.w}; } while (0)
    bf16x8 rk, rv0, rv1;
    rk = *(const bf16x8*)Kp; rv0 = *(const bf16x8*)Vp0; rv1 = *(const bf16x8*)Vp1;
    *(LAS bf16x8*)(KB0 + kso) = rk; ATT_STV(VB0, rv0, rv1);
    rk = *(const bf16x8*)(Kp + (size_t)64 * PLD);
    *(LAS bf16x8*)(KB1 + kso) = rk;
    __syncthreads();
    f32x16 sA0, sA1, sB0, sB1;
#define ATT_QK(D0, D1, KB) do { D0 = nmu; D1 = nmu; \
        _Pragma("unroll") for (int ks = 0; ks < 4; ++ks) { const bf16x8 A0_ = *(const LAS bf16x8*)((KB) + q * LDK + 16 * ks + 8 * hf); D0 = MFMA32(A0_, Bq[ks], D0); } \
        _Pragma("unroll") for (int ks = 0; ks < 4; ++ks) { const bf16x8 A1_ = *(const LAS bf16x8*)((KB) + (32 + q) * LDK + 16 * ks + 8 * hf); D1 = MFMA32(A1_, Bq[ks], D1); } } while (0)
#define ATT_MAX3(d, a, b, c) asm("v_max3_f32 %0, %1, %2, %3" : "=v"(d) : "v"(a), "v"(b), "v"(c))
#define ATT_TMAX(C0, C1, TM) do { float m0_, m1_; ATT_MAX3(m0_, C0[0], C0[1], C0[2]); ATT_MAX3(m1_, C1[0], C1[1], C1[2]); \
        ATT_MAX3(m0_, m0_, C0[3], C0[4]); ATT_MAX3(m1_, m1_, C1[3], C1[4]); ATT_MAX3(m0_, m0_, C0[5], C0[6]); ATT_MAX3(m1_, m1_, C1[5], C1[6]); \
        ATT_MAX3(m0_, m0_, C0[7], C0[8]); ATT_MAX3(m1_, m1_, C1[7], C1[8]); ATT_MAX3(m0_, m0_, C0[9], C0[10]); ATT_MAX3(m1_, m1_, C1[9], C1[10]); \
        ATT_MAX3(m0_, m0_, C0[11], C0[12]); ATT_MAX3(m1_, m1_, C1[11], C1[12]); ATT_MAX3(m0_, m0_, C0[13], C0[14]); ATT_MAX3(m1_, m1_, C1[13], C1[14]); \
        ATT_MAX3(TM, m0_, m1_, C0[15]); TM = fmaxf(TM, C1[15]); TM = fmaxf(TM, __shfl_xor(TM, 32)); } while (0)
#define ATT_RESCALE(C0, C1, N0, N1, TM, FIRST) do { \
        const float delta_ = (FIRST) ? (TM) : fmaxf((TM), 0.f); \
        const float al_ = (FIRST) ? 1.0f : __builtin_amdgcn_exp2f(-delta_); \
        l *= al_; mu += delta_; \
        _Pragma("unroll") for (int i = 0; i < 4; ++i) O[i] *= al_; \
        _Pragma("unroll") for (int r = 0; r < 16; ++r) { C0[r] -= delta_; C1[r] -= delta_; N0[r] -= delta_; N1[r] -= delta_; nmu[r] = -mu; } } while (0)
#define ATT_GROUP(CM, MT, J, VB) do { float pv_[8]; \
        _Pragma("unroll") for (int e = 0; e < 8; ++e) { pv_[e] = __builtin_amdgcn_exp2f(CM[8 * (J) + e]); l += pv_[e]; } \
        const bf16x8 Pf_ = pack8(pv_[0], pv_[1], pv_[2], pv_[3], pv_[4], pv_[5], pv_[6], pv_[7]); \
        _Pragma("unroll") for (int mv = 0; mv < 4; ++mv) { const bf16x8 Av_ = *(const LAS bf16x8*)((VB) + (32 * mv + q) * LDK + 32 * (MT) + 16 * (J) + 8 * hf); O[mv] = MFMA32(Av_, Pf_, O[mv]); } } while (0)
#define ATT_SOFTPV(C0, C1, N0, N1, VC) do { float tm_; ATT_TMAX(C0, C1, tm_); \
        if (__builtin_expect(__any(tm_ > 8.0f), 0)) ATT_RESCALE(C0, C1, N0, N1, tm_, false); \
        ATT_GROUP(C0, 0, 0, VC); ATT_GROUP(C0, 0, 1, VC); ATT_GROUP(C1, 1, 0, VC); ATT_GROUP(C1, 1, 1, VC); } while (0)
#define ATT_STAGE(T, KW, VW) do { *(LAS bf16x8*)((KW) + kso) = rk; ATT_STV(VW, rv0, rv1); \
        __syncthreads(); \
        { const int tk_ = ((T) + 3 < 128) ? (T) + 3 : 127, tv_ = ((T) + 2 < 128) ? (T) + 2 : 127; \
          rk = *(const bf16x8*)(Kp + (size_t)tk_ * 64 * PLD); rv0 = *(const bf16x8*)(Vp0 + tv_ * 64); rv1 = *(const bf16x8*)(Vp1 + tv_ * 64); } } while (0)
#define ATT_ITER(T, C0, C1, N0, N1, KN, VC, KW, VW) do { ATT_QK(N0, N1, KN); ATT_SOFTPV(C0, C1, N0, N1, VC); ATT_STAGE(T, KW, VW); } while (0)
    ATT_QK(sA0, sA1, KB0);
    { float tm_ = fmaxf(sA0[0], sA1[0]);
#pragma unroll
      for (int r = 1; r < 16; ++r) tm_ = fmaxf(tm_, fmaxf(sA0[r], sA1[r]));
      tm_ = fmaxf(tm_, __shfl_xor(tm_, 32)); mu = tm_;
#pragma unroll
      for (int r = 0; r < 16; ++r) { sA0[r] -= tm_; sA1[r] -= tm_; nmu[r] = -tm_; } }
    rk = *(const bf16x8*)(Kp + (size_t)2 * 64 * PLD); rv0 = *(const bf16x8*)(Vp0 + 64); rv1 = *(const bf16x8*)(Vp1 + 64);
    ATT_QK(sB0, sB1, KB1);
    __syncthreads();
    ATT_GROUP(sA0, 0, 0, VB0); ATT_GROUP(sA0, 0, 1, VB0); ATT_GROUP(sA1, 1, 0, VB0); ATT_GROUP(sA1, 1, 1, VB0);
    ATT_STAGE(0, KB0, VB1);
    for (int t = 1; t < 127; t += 2) {
        ATT_ITER(t, sB0, sB1, sA0, sA1, KB0, VB1, KB1, VB0);
        ATT_ITER(t + 1, sA0, sA1, sB0, sB1, KB1, VB0, KB0, VB1);
    }
    ATT_SOFTPV(sB0, sB1, sA0, sA1, VB1);
    __syncthreads();
#undef ATT_QK
#undef ATT_MAX3
#undef ATT_TMAX
#undef ATT_RESCALE
#undef ATT_GROUP
#undef ATT_SOFTPV
#undef ATT_STAGE
#undef ATT_ITER
#undef ATT_STV
    l += __shfl_xor(l, 32);
    const float inv = 1.0f / l;
    bf16_t* op = (bf16_t*)(wsp + WS_RA) + tokq * 2048 + hv * 128 + 4 * hf;
#pragma unroll
    for (int mv = 0; mv < 4; ++mv)
#pragma unroll
        for (int g = 0; g < 4; ++g) { u32x2 o; o.x = pk2(O[mv][4 * g] * inv, O[mv][4 * g + 1] * inv); o.y = pk2(O[mv][4 * g + 2] * inv, O[mv][4 * g + 3] * inv); *(u32x2*)(op + 32 * mv + 8 * g) = o; }
}

DI void unpack16(const u32x4& lo, const u32x4& hi, float (&v)[16]) {
    v[0] = bflo(lo.x); v[1] = bfhi(lo.x); v[2] = bflo(lo.y); v[3] = bfhi(lo.y); v[4] = bflo(lo.z); v[5] = bfhi(lo.z); v[6] = bflo(lo.w); v[7] = bfhi(lo.w);
    v[8] = bflo(hi.x); v[9] = bfhi(hi.x); v[10] = bflo(hi.y); v[11] = bfhi(hi.y); v[12] = bflo(hi.z); v[13] = bfhi(hi.z); v[14] = bflo(hi.w); v[15] = bfhi(hi.w);
}
DI void store16(bf16_t* p, const float (&o)[16]) {
    u32x4 o0, o1; o0.x = pk2(o[0], o[1]); o0.y = pk2(o[2], o[3]); o0.z = pk2(o[4], o[5]); o0.w = pk2(o[6], o[7]); o1.x = pk2(o[8], o[9]); o1.y = pk2(o[10], o[11]); o1.z = pk2(o[12], o[13]); o1.w = pk2(o[14], o[15]);
    *(u32x4*)p = o0; *(u32x4*)(p + 8) = o1;
}
DI void p3_headnorm(int tid) {
    const int lane = tid & 63, w = tid >> 6; const int nw = gridDim.x * 8;
    unsigned char* const wsp = KWS;
    const bf16_t* HF = (const bf16_t*)KOUT; const bf16_t* HB = HF + (size_t)T_ * 1024; const bf16_t* OA = (const bf16_t*)(wsp + WS_RA);
    const bf16_t* proj = (const bf16_t*)(wsp + WS_PROJ);
    bf16_t* HMG = (bf16_t*)(wsp + WS_XT); bf16_t* HAN = HMG + (size_t)T_ * 1024;
    const float lam = *(const float*)(wsp + WS_MISC + 64);
    const float* mw = KIN(6); const float* aw = KIN(11);
    const int col = (lane >> 4) * 256 + (lane & 15) * 16;
    const int hd = lane >> 3, vo = (lane & 7) * 16;
    for (int tp = blockIdx.x * 8 + w; tp < T_ / 2; tp += nw) {
        u32x4 f[2][2], bb[2][2], g[2][2], a[2][2], c[2][2];
#pragma unroll
        for (int h = 0; h < 2; ++h) { const size_t t = (size_t)(2 * tp + h);
            f[h][0] = *(const u32x4*)(HF + t * 1024 + col); f[h][1] = *(const u32x4*)(HF + t * 1024 + col + 8);
            bb[h][0] = *(const u32x4*)(HB + t * 1024 + col); bb[h][1] = *(const u32x4*)(HB + t * 1024 + col + 8);
            g[h][0] = *(const u32x4*)(proj + t * PLD + 1024 + col); g[h][1] = *(const u32x4*)(proj + t * PLD + 1024 + col + 8);
            const bf16_t* p0 = OA + t * 2048 + (2 * hd) * 128 + vo;
            a[h][0] = *(const u32x4*)p0; a[h][1] = *(const u32x4*)(p0 + 8); c[h][0] = *(const u32x4*)(p0 + 128); c[h][1] = *(const u32x4*)(p0 + 136); }
#pragma unroll
        for (int h = 0; h < 2; ++h) { const size_t t = (size_t)(2 * tp + h);
            {
                float vf[16], vb[16], gt[16], v[16], o[16];
                unpack16(f[h][0], f[h][1], vf); unpack16(bb[h][0], bb[h][1], vb); unpack16(g[h][0], g[h][1], gt);
                float s = 0.f;
#pragma unroll
                for (int i = 0; i < 16; ++i) { v[i] = vf[i] + vb[i]; s += v[i] * v[i]; }
                s += __shfl_xor(s, 1); s += __shfl_xor(s, 2); s += __shfl_xor(s, 4); s += __shfl_xor(s, 8);
                const float r = rsqrtf(s * (1.0f / 256.0f) + EPS_);
#pragma unroll
                for (int i = 0; i < 16; ++i) o[i] = v[i] * r * mw[col + i] * gt[i];
                store16(HMG + t * 1024 + col, o);
            }
            {
                float va[16], vc[16], v[16], o[16];
                unpack16(a[h][0], a[h][1], va); unpack16(c[h][0], c[h][1], vc);
                float s = 0.f;
#pragma unroll
                for (int i = 0; i < 16; ++i) { v[i] = va[i] - lam * vc[i]; s += v[i] * v[i]; }
                s += __shfl_xor(s, 1); s += __shfl_xor(s, 2); s += __shfl_xor(s, 4);
                const float r = rsqrtf(s * (1.0f / 128.0f) + EPS_) * 0.8f;
#pragma unroll
                for (int i = 0; i < 16; ++i) o[i] = v[i] * r * aw[vo + i];
                store16(HAN + t * 1024 + hd * 128 + vo, o);
            }
        }
    }
}

#define XB_TMO      128
#define XB_XCNT(j)  (256  + 64 * (j))
#define XB_XSUB(j)  (1280 + 64 * (j))
#define XB_XGEN(j)  (2304 + 64 * (j))
#define XB_TOP      3328
#define XB_TOPGEN   3392
#define XCD_BAR_WORDS 3456
#define XB_SPIN_CAP (1u << 18)

__device__ __forceinline__ unsigned xb_ld(unsigned* p)              { return __hip_atomic_load(p, __ATOMIC_RELAXED, __HIP_MEMORY_SCOPE_AGENT); }
__device__ __forceinline__ unsigned xb_add(unsigned* p, unsigned v) { return __hip_atomic_fetch_add(p, v, __ATOMIC_RELAXED, __HIP_MEMORY_SCOPE_AGENT); }
__device__ __forceinline__ unsigned xb_xcc_id() { return (unsigned)__builtin_amdgcn_s_getreg((3 << 11) | 20) & 0xFu; }
#define XB_SPIN(cond, bar) do { unsigned _sp = 0; while (cond) { __builtin_amdgcn_s_sleep(1); \
    if ((++_sp & 255u) == 0u) { if (xb_ld(&(bar)[XB_TMO])) break; if (_sp > XB_SPIN_CAP) { atomicAdd(&(bar)[XB_TMO], 1u); break; } } } } while (0)

struct XcdBarrier {
    unsigned* bar; unsigned x;
    volatile LAS unsigned* st;
};

__device__ __forceinline__ XcdBarrier xcd_barrier_post(unsigned* bar, volatile LAS unsigned* st) {
    XcdBarrier b; b.bar = bar; b.x = xb_xcc_id(); b.st = st;
    if (threadIdx.x == 0) (void)xb_add(&bar[XB_XCNT(b.x)], 1u);
    return b;
}
__device__ __forceinline__ void xcd_barrier_complete(unsigned* bar, unsigned x, unsigned& nloc, unsigned& nx) {
    const unsigned G = gridDim.x * gridDim.y * gridDim.z;
    unsigned sum, cnt, mine, sp = 0u;
    for (;;) {
        sum = 0u; cnt = 0u; mine = 0u;
#pragma unroll
        for (unsigned j = 0; j < 16; ++j) { const unsigned c = xb_ld(&bar[XB_XCNT(j)]); sum += c; cnt += (c > 0u) ? 1u : 0u; mine = (j == x) ? c : mine; }
        if (sum == G) break;
        __builtin_amdgcn_s_sleep(1);
        if ((++sp & 255u) == 0u) { if (xb_ld(&bar[XB_TMO])) break; if (sp > XB_SPIN_CAP) { atomicAdd(&bar[XB_TMO], 1u); break; } }
    }
    nloc = mine > 0u ? mine : 1u; nx = cnt > 0u ? cnt : 1u;
}

__device__ __forceinline__ void xcd_barrier(const XcdBarrier& b) {
    asm volatile("s_waitcnt vmcnt(0)" ::: "memory");
    __syncthreads();
    if (threadIdx.x == 0) {
        unsigned* bar = b.bar;
        __builtin_amdgcn_s_waitcnt(0);
        unsigned nloc = b.st[0], nx = b.st[1];
        if (nloc == 0u) { xcd_barrier_complete(bar, b.x, nloc, nx); b.st[0] = nloc; b.st[1] = nx; }
        const unsigned old = xb_add(&bar[XB_XSUB(b.x)], 1u);
        const unsigned gen = old / nloc;
        if (old + 1u == (gen + 1u) * nloc) {
            __builtin_amdgcn_fence(__ATOMIC_RELEASE, "agent");
            asm volatile("s_waitcnt vmcnt(0)" ::: "memory");
            const unsigned og = xb_add(&bar[XB_TOP], 1u);
            const unsigned tg = og / nx;
            if (og + 1u == (tg + 1u) * nx) xb_add(&bar[XB_TOPGEN], 1u);
            else XB_SPIN(xb_ld(&bar[XB_TOPGEN]) == tg, bar);
            __builtin_amdgcn_fence(__ATOMIC_ACQUIRE, "agent");
            xb_add(&bar[XB_XGEN(b.x)], 1u);
            asm volatile("s_waitcnt vmcnt(0)" ::: "memory");
        } else {
            XB_SPIN(xb_ld(&bar[XB_XGEN(b.x)]) == gen, bar);
            __builtin_amdgcn_fence(__ATOMIC_ACQUIRE, "agent");
            asm volatile("s_waitcnt vmcnt(0)" ::: "memory");
        }
    }
    __syncthreads();
}


__global__ void __launch_bounds__(512) fwd_mega(Params Punused) {
    extern __shared__ __attribute__((aligned(16))) unsigned char lds_raw[];
    LAS unsigned char* lds = (LAS unsigned char*)lds_raw;
    cg::grid_group grid = cg::this_grid();
    { LAS unsigned* xw = (LAS unsigned*)(lds + LDS_STAGE + 16); if (threadIdx.x < 2) xw[threadIdx.x] = 0u; __syncthreads(); }
    const int G = gridDim.x, bx = blockIdx.x;
    unsigned char* ws = KWS;
    unsigned* counter = (unsigned*)(ws + WS_MISC);
    bf16_t* const H = (bf16_t*)(ws + WS_RA);
    bf16_t* const PROJ = (bf16_t*)(ws + WS_PROJ);
    bf16_t* const XT = (bf16_t*)(ws + WS_XT);

    for (int rep = 0; rep < REP_P0; ++rep) {
        const int tid = fresh_tid();
        int total = 0;
        for (int i = 0; i < NREG; ++i) total += c_regs[i].ngroups * (c_regs[i].K >> 6);
        conv_units(bx, total, G, (LAS float*)lds, tid);
        p0_norm_gates((LAS float*)lds, tid);
        float* cosT = (float*)(ws + WS_COS); float* sinT = (float*)(ws + WS_SIN);
        for (int idx = bx * 512 + tid; idx < S_ * 32; idx += G * 512) {
            const int pos = idx >> 5, j = idx & 31; const float ang = (float)pos * c_inv[j];
            const double rev = (double)ang * 0.15915494309189535; const float f = (float)(rev - rint(rev));
            cosT[idx] = __builtin_amdgcn_cosf(f); sinT[idx] = __builtin_amdgcn_sinf(f);
        }
        if (bx == 0) { unsigned* bw = (unsigned*)(ws + WS_BAR); for (int q = tid; q < XCD_BAR_WORDS; q += 512) bw[q] = 0u; }
        if (bx == 0 && tid == 0) {
            counter[0] = 0u; counter[1] = 0u; counter[2] = 0u; counter[3] = 0u;
            float d1 = 0.f, d2 = 0.f;
            const float* l1 = KIN(7); const float* l2 = KIN(8); const float* l3 = KIN(9); const float* l4 = KIN(10);
            for (int i = 0; i < 64; ++i) { d1 += l1[i] * l2[i]; d2 += l3[i] * l4[i]; }
            *(float*)(ws + WS_MISC + 64) = expf(d1) - expf(d2) + 0.2f;
        }
    }
    grid.sync();
    const XcdBarrier xbar = xcd_barrier_post((unsigned*)(KWS + WS_BAR), (volatile LAS unsigned*)(lds + LDS_STAGE + 16));
    for (int rep = 0; rep < REP_P1; ++rep) {
        gate_prep(fresh_tid());
        { pg8::Gemm g{H, (const bf16_t*)(ws + WS_W1T), T_, 8192, 2048}; pg8::StaticOrder S; S.init(T_, 8192, G, bx);
          EpiMain E{PROJ, (bf16_t*)(ws + WS_GT), KIN(5), (const float*)(ws + WS_COS), (const float*)(ws + WS_SIN)};
          pg8::gemm_phase<EpiMain, pg8::StaticOrder, false>(lds, g, S, E, nullptr); }
        { pg8::Gemm g{(const bf16_t*)(ws + WS_W2T), H, 2048, T_, 2048}; pg8::StaticOrder S; S.init(2048, T_, G, bx);
          EpiPlain E{XT, T_};
          pg8::gemm_phase<EpiPlain, pg8::StaticOrder, false>(lds, g, S, E, nullptr); }
    }
    xcd_barrier(xbar);
    for (int rep = 0; rep < REP_P2; ++rep) {
        if (rep) grid.sync();
        unsigned* counter = (unsigned*)(ws + WS_MISC) + rep;
        const int tid = fresh_tid();
        LAS int* qw = (LAS int*)(lds + LDS_STAGE);
#define GRAB(dst) do { if (tid == 0) *qw = (int)atomicAdd(counter, 1u); __syncthreads(); dst = *qw; __syncthreads(); } while (0)
        int item; GRAB(item);
#ifndef NO_MLSTM
        while (item < N_MLSTM_ITEMS) { mlstm_item(item, lds, tid); GRAB(item); }
#endif
#ifndef NO_ATTN
        while (item < N_MLSTM_ITEMS + N_ATTN_ITEMS) { attn_item(item - N_MLSTM_ITEMS, lds, tid); GRAB(item); }
#endif
#undef GRAB
    }
    xcd_barrier(xbar);
    for (int rep = 0; rep < REP_P3; ++rep) p3_headnorm(fresh_tid());
    xcd_barrier(xbar);
    for (int rep = 0; rep < REP_P4; ++rep) {
        pg8::Gemm g{XT, (const bf16_t*)(ws + WS_WBM), 2 * T_, 4096, 1024}; BranchOrder S; S.init(T_, 2048, G, bx);
        EpiBranchChain E{(const bf16_t*)(ws + WS_GT), H}; pg8::gemm_phase<EpiBranchChain, BranchOrder, false>(lds, g, S, E, nullptr);
    }
    xcd_barrier(xbar);
    for (int rep = 0; rep < REP_P5; ++rep) {
        pg8::Gemm g{H, (const bf16_t*)(ws + WS_WOUT), T_, 2048, 2048}; pg8::StaticOrder S; S.init(T_, 2048, G, bx);
        EpiResidBf E{KIN(0), XT}; pg8::gemm_phase<EpiResidBf, pg8::StaticOrder, false>(lds, g, S, E, nullptr);
    }
    xcd_barrier(xbar);
    for (int rep = 0; rep < REP_P6; ++rep) rows_rmsnorm_bf<true>(XT, KIN(15), H, nullptr, fresh_tid());
    xcd_barrier(xbar);
    for (int rep = 0; rep < REP_P7; ++rep) {
        pg8::Gemm g{H, (const bf16_t*)(ws + WS_WFFI), T_, 2 * DFF_, 2048}; pg8::StaticOrder S; S.init(T_, 2 * DFF_, G, bx);
        EpiSwiglu E{PROJ}; pg8::gemm_phase<EpiSwiglu, pg8::StaticOrder, false>(lds, g, S, E, nullptr);
    }
    xcd_barrier(xbar);
    if (!SKIP_P8) {
        pg8::Gemm g{PROJ, (const bf16_t*)(ws + WS_WFFO), T_, 2048, DFF_}; pg8::StaticOrder S; S.init(T_, 2048, G, bx);
        EpiResidBfBf E{XT, (bf16_t*)(ws + WS_X2)}; pg8::gemm_phase<EpiResidBfBf, pg8::StaticOrder, false>(lds, g, S, E, nullptr);
    }
    xcd_barrier(xbar);
    if (!SKIP_P9) rows_rmsnorm_bf<false>((const bf16_t*)(ws + WS_X2), KIN(18), nullptr, KOUT, fresh_tid());
}

extern "C" void kernel_launch(void* const* d_in, const int* in_sizes, int n_in, void* d_out, int out_size, void* d_ws, size_t ws_size, hipStream_t stream) {
    static int grid_blocks = 0;
    if (!grid_blocks) {
        int dev = 0, cus = 0, per_cu = 0;
        (void)hipGetDevice(&dev);
        (void)hipDeviceGetAttribute(&cus, hipDeviceAttributeMultiprocessorCount, dev);
        (void)hipFuncSetAttribute((const void*)fwd_mega, hipFuncAttributeMaxDynamicSharedMemorySize, LDS_BYTES);
        (void)hipOccupancyMaxActiveBlocksPerMultiprocessor(&per_cu, (const void*)fwd_mega, 512, LDS_BYTES);
        if (per_cu < 1) per_cu = 1;
        grid_blocks = cus * per_cu;
        if (n_in != 19 || ws_size < 940 * MIB) fprintf(stderr, "kernel_launch: unexpected n_in %d / ws_size %zu\n", n_in, ws_size);
    }
    Params p{};
    for (int i = 0; i < 19; ++i) p.in[i] = (const float*)d_in[i];
    p.out = (float*)d_out; p.ws = (unsigned char*)d_ws;
    void* args[] = {&p};
    hipError_t e = hipLaunchCooperativeKernel((const void*)fwd_mega, dim3(grid_blocks), dim3(512), args, LDS_BYTES, stream);
    if (e != hipSuccess) fprintf(stderr, "cooperative launch failed: %s (grid %d)\n", hipGetErrorString(e), grid_blocks);
}
```
